# Optimizing an MI355X kernel written in HIP

```python
import math
import jax, jax.numpy as jnp
from jax import lax
import numpy as np

D_MODEL = 2048
BATCH = 8
SEQ = 2048
DEPTH = 2
DEC_BATCH = 32
DEC_SEQ = 1
PAST_LEN = 8192
PAGE_SIZE = 128

N_EVEN = (DEPTH + 1) // 2
N_ODD = DEPTH // 2

A_HEAD_DIM = 128
A_HEADS = D_MODEL // (2 * A_HEAD_DIM)
A_WIDTH = A_HEADS * A_HEAD_DIM
DILATION_PATTERNS = ((128, 1), (512, 4), (2048, 16))
WINDOW_MAX = 2048
QBLK = 128

REL_BUCKETS = 32
REL_MAX_DIST = 2048

CHUNK = 128
B_GROUP_CH = 128
B_WIDTH = D_MODEL // 2
B_GROUPS = B_WIDTH // B_GROUP_CH

AB_COLS = 4 * A_WIDTH + 3 * B_WIDTH
AB_SPLITS = (A_WIDTH, 2 * A_WIDTH, 3 * A_WIDTH, 4 * A_WIDTH, 4 * A_WIDTH + B_WIDTH, 4 * A_WIDTH + 2 * B_WIDTH)

C_HEAD_DIM = 64
C_HEADS = D_MODEL // C_HEAD_DIM
C_DECAY_LORA = 96
C_ICLR_LORA = 96

PLE_DIM = 256
RMS_EPS = 1e-6
LN_EPS = 1e-5
GN_EPS = 64e-5
NEG_INF = -1e30

kernel_name = 'hybrid_dilated_gmlp_rwkv7_step'


def rms_norm(x, g):
    xf = x.astype(jnp.float32)
    y = xf * lax.rsqrt(jnp.mean(xf * xf, axis=-1, keepdims=True) + RMS_EPS)
    return (y * g.astype(jnp.float32)).astype(x.dtype)


def layer_norm(x, g, b):
    xf = x.astype(jnp.float32)
    mu = jnp.mean(xf, axis=-1, keepdims=True)
    var = jnp.mean(jnp.square(xf - mu), axis=-1, keepdims=True)
    return ((xf - mu) * lax.rsqrt(var + LN_EPS) * g.astype(jnp.float32) + b.astype(jnp.float32)).astype(x.dtype)


def t5_bucket(dist):
    n_exact = REL_BUCKETS // 2
    d = jnp.maximum(dist, 1).astype(jnp.float32)
    log_b = n_exact + (jnp.log(d / n_exact) / math.log(REL_MAX_DIST / n_exact) * (REL_BUCKETS - n_exact)).astype(jnp.int32)
    return jnp.where(dist < n_exact, dist, jnp.minimum(log_b, REL_BUCKETS - 1))


def dilated_attn_prompt(q, k, v, rel_bias, window, dil):
    Bn, S, H, E = q.shape
    n_steps = window // dil
    span = dil * QBLK
    Sp = -(-S // span) * span
    nb = Sp // span

    def blocks(t):
        t = jnp.pad(t, ((0, 0), (0, Sp - S), (0, 0), (0, 0)))
        return t.reshape(Bn, nb, QBLK, dil, H, E)

    def with_prev(t):
        prev = jnp.pad(t, ((0, 0), (1, 0), (0, 0), (0, 0), (0, 0), (0, 0)))[:, :-1]
        return jnp.concatenate([prev, t], axis=2)

    qb = blocks(q)
    kc = with_prev(blocks(k))
    vc = with_prev(blocks(v))
    s = jnp.einsum('bnirhe,bnjrhe->bnrhij', qb, kc, preferred_element_type=jnp.float32) * (E ** -0.5)
    i = jnp.arange(QBLK)[:, None]
    j = jnp.arange(2 * QBLK)[None, :]
    steps = QBLK + i - j
    band = (steps >= 0) & (steps <= n_steps)
    has_prev = (jnp.arange(nb)[:, None, None] > 0) | (j >= QBLK)[None]
    valid = band[None] & has_prev
    bias = jnp.moveaxis(rel_bias[t5_bucket(jnp.clip(steps, 0) * dil)], -1, 0).astype(jnp.float32)
    s = jnp.where(valid[None, :, None, None], s + bias, NEG_INF)
    lse = jax.nn.logsumexp(s, axis=-1)
    p = jnp.exp(s - lse[..., None]).astype(v.dtype)
    o = jnp.einsum('bnrhij,bnjrhe->bnirhe', p, vc, preferred_element_type=jnp.float32)
    o = o.reshape(Bn, Sp, H, E)[:, :S]
    lse = jnp.transpose(lse, (0, 1, 4, 2, 3)).reshape(Bn, Sp, H)[:, :S]
    return o, lse


def dilated_attn_sample(q, k_all, v_all, rel_bias, window, dil):
    T, E = q.shape[1], q.shape[-1]
    L = k_all.shape[1] - T
    back = jnp.arange(window // dil + 1)
    idx = L + jnp.arange(T)[:, None] - back[None, :] * dil
    valid = idx >= 0
    idx = jnp.maximum(idx, 0)
    kg = k_all[:, idx]
    vg = v_all[:, idx]
    s = jnp.einsum('bthe,btshe->bths', q, kg, preferred_element_type=jnp.float32) * (E ** -0.5)
    bias = rel_bias[t5_bucket(back * dil)].T.astype(jnp.float32)
    s = jnp.where(valid[None, :, None, :], s + bias, NEG_INF)
    lse = jax.nn.logsumexp(s, axis=-1)
    p = jnp.exp(s - lse[..., None]).astype(vg.dtype)
    o = jnp.einsum('bths,btshe->bthe', p, vg, preferred_element_type=jnp.float32)
    return o, lse


def mix_by_denominator(results):
    outs, lses = zip(*results)
    wts = jax.nn.softmax(jnp.stack(lses), axis=0)
    return jnp.einsum('pbth,pbthe->bthe', wts, jnp.stack(outs))


def chunk_spatial_mix(v, w_s, b_s):
    Bn, T, G, C = v.shape
    Tp = -(-T // CHUNK) * CHUNK
    vp = jnp.pad(v, ((0, 0), (0, Tp - T), (0, 0), (0, 0))).reshape(Bn, Tp // CHUNK, CHUNK, G, C)
    w = w_s * jnp.tril(jnp.ones((CHUNK, CHUNK), w_s.dtype))
    out = jnp.einsum('gij,bnjgc->bnigc', w, vp) + b_s.T[None, None, :, :, None]
    return out.reshape(Bn, Tp, G, C)[:, :T]


def ab_layer(xn, attend_a, w_in, w_out, w_s, b_s, ln_g, ln_b):
    Bn, T, _ = xn.shape
    z = xn @ w_in
    q, k, v, g_a, u_b, v_b, g_b = jnp.split(z, AB_SPLITS, axis=-1)
    heads = lambda t: t.reshape(Bn, T, A_HEADS, A_HEAD_DIM)
    k_h, v_h = heads(k), heads(v)
    o_a = attend_a(heads(q), k_h, v_h).reshape(Bn, T, A_WIDTH).astype(xn.dtype)
    vn = layer_norm(jax.nn.gelu(v_b), ln_g, ln_b)
    s_b = chunk_spatial_mix(vn.reshape(Bn, T, B_GROUPS, B_GROUP_CH), w_s, b_s).reshape(Bn, T, B_WIDTH)
    o_b = jax.nn.gelu(u_b) * s_b.astype(xn.dtype)
    y = jnp.concatenate([o_a * jax.nn.silu(g_a), o_b * jax.nn.silu(g_b)], axis=-1) @ w_out
    return y, k_h, v_h, vn


def rwkv7_time_mix(xn, shift_prev, wkv_prev, mu, w_r, w_k, w_v, w_g, w_o, w0, w1, w2, a0, a1, a2, k_k, k_a, r_k, gn_g, gn_b):
    Bn, T, D = xn.shape
    H, N = C_HEADS, C_HEAD_DIM
    f32 = jnp.float32
    x_prev = jnp.concatenate([shift_prev[:, None, :].astype(xn.dtype), xn[:, :-1]], axis=1)
    xx = x_prev - xn
    xr, xw, xk, xv, xa, xg = (xn + xx * mu[m] for m in range(6))
    r = (xr @ w_r).astype(f32)
    k = (xk @ w_k).astype(f32)
    v = (xv @ w_v).astype(f32)
    g = jax.nn.silu(xg @ w_g)
    w_log = -jax.nn.softplus(-(w0 + jnp.tanh(xw @ w1) @ w2).astype(f32)) - 0.5
    decay = jnp.exp(-jnp.exp(w_log))
    a = jax.nn.sigmoid((a0 + (xa @ a1) @ a2).astype(f32))
    heads = lambda t: t.reshape(Bn, T, H, N)
    kk = heads(k * k_k.astype(f32))
    kk = kk / jnp.maximum(jnp.sqrt(jnp.sum(kk * kk, axis=-1, keepdims=True)), 1e-12)
    k = k * (1.0 + (a - 1.0) * k_a.astype(f32))
    r_h, w_h, k_h, v_h, a_h = heads(r), heads(decay), heads(k), heads(v), heads(a)

    def step(S, inp):
        r_t, w_t, k_t, v_t, kk_t, a_t = inp
        sa = jnp.einsum('bhij,bhj->bhi', S, -kk_t)
        S = S * w_t[:, :, None, :] + sa[..., :, None] * (kk_t * a_t)[..., None, :] + v_t[..., :, None] * k_t[..., None, :]
        return S, jnp.einsum('bhij,bhj->bhi', S, r_t)

    tm = lambda t: jnp.moveaxis(t, 1, 0)
    S_final, y = lax.scan(step, wkv_prev.astype(f32), (tm(r_h), tm(w_h), tm(k_h), tm(v_h), tm(kk), tm(a_h)))
    y = jnp.moveaxis(y, 0, 1)
    mean = jnp.mean(y, axis=-1, keepdims=True)
    var = jnp.mean(jnp.square(y - mean), axis=-1, keepdims=True)
    y = (y - mean) * lax.rsqrt(var + GN_EPS) * gn_g.reshape(H, N).astype(f32) + gn_b.reshape(H, N).astype(f32)
    y = y + jnp.sum(r_h * k_h * r_k.astype(f32), axis=-1, keepdims=True) * v_h
    out = (y.reshape(Bn, T, D).astype(xn.dtype) * g) @ w_o
    return out, S_final, xn[:, -1]


def per_layer_input(h, p, w_proj, w_gate):
    return jax.nn.sigmoid(h @ w_gate) * (p @ w_proj)


def setup_inputs(seed: int = 0) -> dict:
    key = jax.random.key(seed)
    ks = iter(jax.random.split(key, 48))
    nrm = lambda shape, scale: jax.random.normal(next(ks), shape, jnp.float32) * scale
    D = D_MODEL
    win_s = min(WINDOW_MAX, PAST_LEN)
    return {
        'x_prompt': nrm((BATCH, SEQ, D), 1.0),
        'x_sample': nrm((DEC_BATCH, DEC_SEQ, D), 1.0),
        'cache_a_k': nrm((N_EVEN, DEC_BATCH, win_s, A_HEADS, A_HEAD_DIM), 1.0),
        'cache_a_v': nrm((N_EVEN, DEC_BATCH, win_s, A_HEADS, A_HEAD_DIM), 1.0),
        'state_c_wkv': nrm((N_ODD, DEC_BATCH, C_HEADS, C_HEAD_DIM, C_HEAD_DIM), 0.1),
        'state_c_shift': nrm((N_ODD, DEC_BATCH, D), 1.0),
        'p_prompt': nrm((DEPTH, BATCH, SEQ, PLE_DIM), 1.0),
        'p_sample': nrm((DEPTH, DEC_BATCH, DEC_SEQ, PLE_DIM), 1.0),
        'norm_g': 1.0 + nrm((DEPTH, D), 0.02),
        'final_norm_g': 1.0 + nrm((D,), 0.02),
        'rel_bias': nrm((REL_BUCKETS, A_HEADS), 0.5),
        'ab_w_in': nrm((N_EVEN, D, AB_COLS), D ** -0.5),
        'ab_w_out': nrm((N_EVEN, A_WIDTH + B_WIDTH, D), (A_WIDTH + B_WIDTH) ** -0.5),
        'b_w_s': nrm((N_EVEN, B_GROUPS, CHUNK, CHUNK), CHUNK ** -0.5),
        'b_b_s': 1.0 + nrm((N_EVEN, B_GROUPS, CHUNK), 0.1),
        'b_ln_g': 1.0 + nrm((N_EVEN, B_WIDTH), 0.02),
        'b_ln_b': nrm((N_EVEN, B_WIDTH), 0.02),
        'c_mu': jax.random.uniform(next(ks), (N_ODD, 6, D), jnp.float32),
        'c_w_r': nrm((N_ODD, D, D), D ** -0.5),
        'c_w_k': nrm((N_ODD, D, D), D ** -0.5),
        'c_w_v': nrm((N_ODD, D, D), D ** -0.5),
        'c_w_g': nrm((N_ODD, D, D), D ** -0.5),
        'c_w_o': nrm((N_ODD, D, D), D ** -0.5),
        'c_w0': -2.0 + nrm((N_ODD, D), 0.5),
        'c_w1': nrm((N_ODD, D, C_DECAY_LORA), D ** -0.5),
        'c_w2': nrm((N_ODD, C_DECAY_LORA, D), 0.5 * C_DECAY_LORA ** -0.5),
        'c_a0': nrm((N_ODD, D), 0.1),
        'c_a1': nrm((N_ODD, D, C_ICLR_LORA), D ** -0.5),
        'c_a2': nrm((N_ODD, C_ICLR_LORA, D), 0.5 * C_ICLR_LORA ** -0.5),
        'c_k_k': 0.85 + nrm((N_ODD, D), 0.05),
        'c_k_a': 1.0 + nrm((N_ODD, D), 0.05),
        'c_r_k': nrm((N_ODD, C_HEADS, C_HEAD_DIM), 0.1),
        'c_gn_g': 1.0 + nrm((N_ODD, D), 0.02),
        'c_gn_b': nrm((N_ODD, D), 0.02),
        'ple_w_proj': nrm((DEPTH, PLE_DIM, D), 0.5 * PLE_DIM ** -0.5),
        'ple_w_gate': nrm((DEPTH, D, D), D ** -0.5),
    }


def reference(x_prompt, x_sample, cache_a_k, cache_a_v, state_c_wkv, state_c_shift, p_prompt, p_sample,
              norm_g, final_norm_g, rel_bias, ab_w_in, ab_w_out, b_w_s, b_b_s, b_ln_g, b_ln_b,
              c_mu, c_w_r, c_w_k, c_w_v, c_w_g, c_w_o, c_w0, c_w1, c_w2, c_a0, c_a1, c_a2,
              c_k_k, c_k_a, c_r_k, c_gn_g, c_gn_b, ple_w_proj, ple_w_gate):
    hp, hs = x_prompt, x_sample
    Bp, Sp_len = x_prompt.shape[0], x_prompt.shape[1]
    win_p = min(WINDOW_MAX, Sp_len)
    a_k_p, a_v_p, a_k_s, a_v_s, b_v_s = [], [], [], [], []
    c_S_p, c_x_p, c_S_s, c_x_s = [], [], [], []

    def attend_prompt(q, k, v):
        return mix_by_denominator([dilated_attn_prompt(q, k, v, rel_bias, w, d) for w, d in DILATION_PATTERNS])

    for i in range(DEPTH):
        j = i // 2
        xp = rms_norm(hp, norm_g[i])
        xs = rms_norm(hs, norm_g[i])
        if i % 2 == 0:
            ab_w = (ab_w_in[j], ab_w_out[j], b_w_s[j], b_b_s[j], b_ln_g[j], b_ln_b[j])
            mp, k_p, v_p, _ = ab_layer(xp, attend_prompt, *ab_w)
            ck, cv = cache_a_k[j], cache_a_v[j]

            def attend_sample(q, k, v, ck=ck, cv=cv):
                k_all = jnp.concatenate([ck.astype(k.dtype), k], axis=1)
                v_all = jnp.concatenate([cv.astype(v.dtype), v], axis=1)
                return mix_by_denominator([dilated_attn_sample(q, k_all, v_all, rel_bias, w, d) for w, d in DILATION_PATTERNS])

            ms, k_s, v_s, vn_s = ab_layer(xs, attend_sample, *ab_w)
            a_k_p.append(k_p[:, -win_p:])
            a_v_p.append(v_p[:, -win_p:])
            a_k_s.append(k_s)
            a_v_s.append(v_s)
            b_v_s.append(vn_s)
        else:
            c_w = (c_mu[j], c_w_r[j], c_w_k[j], c_w_v[j], c_w_g[j], c_w_o[j], c_w0[j], c_w1[j], c_w2[j],
                   c_a0[j], c_a1[j], c_a2[j], c_k_k[j], c_k_a[j], c_r_k[j], c_gn_g[j], c_gn_b[j])
            mp, S_p, sh_p = rwkv7_time_mix(xp, jnp.zeros((Bp, D_MODEL), xp.dtype),
                                           jnp.zeros((Bp, C_HEADS, C_HEAD_DIM, C_HEAD_DIM), jnp.float32), *c_w)
            ms, S_s, sh_s = rwkv7_time_mix(xs, state_c_shift[j], state_c_wkv[j], *c_w)
            c_S_p.append(S_p)
            c_x_p.append(sh_p)
            c_S_s.append(S_s)
            c_x_s.append(sh_s)
        hp = hp + mp
        hs = hs + ms
        hp = hp + per_layer_input(hp, p_prompt[i], ple_w_proj[i], ple_w_gate[i])
        hs = hs + per_layer_input(hs, p_sample[i], ple_w_proj[i], ple_w_gate[i])

    y_prompt = rms_norm(hp, final_norm_g)
    y_sample = rms_norm(hs, final_norm_g)
    return (y_prompt, y_sample, jnp.stack(a_k_p), jnp.stack(a_v_p), jnp.stack(a_k_s), jnp.stack(a_v_s),
            jnp.stack(b_v_s), jnp.stack(c_S_p), jnp.stack(c_x_p), jnp.stack(c_S_s), jnp.stack(c_x_s))
```

```cpp
#include <hip/hip_runtime.h>
#include <cstdio>
#include <cstdint>

#define LAS __attribute__((address_space(3)))
#define GAS __attribute__((address_space(1)))
typedef unsigned short bf16_t;
typedef short bf16x8 __attribute__((ext_vector_type(8)));
typedef float f32x4 __attribute__((ext_vector_type(4)));
typedef float f32x2 __attribute__((ext_vector_type(2)));
typedef unsigned u32x4 __attribute__((ext_vector_type(4)));
typedef unsigned u32x2 __attribute__((ext_vector_type(2)));

#ifndef N_LAUNCH_MODE
#define N_LAUNCH_MODE 1
#endif

constexpr int D = 2048, NBATCH = 8, SEQ = 2048, MPR = NBATCH * SEQ  , NS = 32, MV = MPR + NS  , MP = 16640  ;
constexpr int AW = 1024, NIN = 7168, PLE = 256, HC = 64  , NHC = 32;
constexpr float RMS_EPS = 1e-6f, LN_EPS = 1e-5f, GN_EPS = 64e-5f;

__device__ __forceinline__ unsigned f2bf(float f) { unsigned u = __builtin_bit_cast(unsigned, f); return (u + 0x7fffu + ((u >> 16) & 1u)) >> 16; }
__device__ __forceinline__ unsigned pk2(float lo, float hi) { return f2bf(lo) | (f2bf(hi) << 16); }
typedef __bf16 bf16x2_t __attribute__((ext_vector_type(2)));
__device__ __forceinline__ unsigned cvt_pk_bf16(float lo, float hi) { const f32x2 v = {lo, hi}; const bf16x2_t b = __builtin_convertvector(v, bf16x2_t); return __builtin_bit_cast(unsigned, b); }
__device__ __forceinline__ float bflo(unsigned u) { return __builtin_bit_cast(float, u << 16); }
__device__ __forceinline__ float bfhi(unsigned u) { return __builtin_bit_cast(float, u & 0xffff0000u); }
__device__ __forceinline__ float bf1(bf16_t b) { return __builtin_bit_cast(float, ((unsigned)b) << 16); }
__device__ __forceinline__ float fast_rcp(float x) { return __builtin_amdgcn_rcpf(x); }
__device__ __forceinline__ float fast_exp(float x) { return __builtin_amdgcn_exp2f(x * 1.4426950408889634f); }
__device__ __forceinline__ float sigmoidf_(float x) { return fast_rcp(1.0f + fast_exp(-x)); }
__device__ __forceinline__ float siluf_(float x) { return x * sigmoidf_(x); }
__device__ __forceinline__ float gelu_tanh_(float x) { const float z = 1.5957691216057308f * (x + 0.044715f * x * x * x); return x * sigmoidf_(z); }
__device__ __forceinline__ float tanhf_(float x) { return 2.0f * sigmoidf_(2.0f * x) - 1.0f; }
__device__ __forceinline__ float wave_sum(float v) {
#pragma unroll
    for (int o = 1; o < 64; o <<= 1) v += __shfl_xor(v, o);
    return v;
}
__device__ __forceinline__ float wave_max(float v) {
#pragma unroll
    for (int o = 1; o < 64; o <<= 1) v = fmaxf(v, __shfl_xor(v, o));
    return v;
}
template <int CTRL> __device__ __forceinline__ float dpp_f(float x) { return __builtin_bit_cast(float, __builtin_amdgcn_update_dpp(0, __builtin_bit_cast(int, x), CTRL, 0xf, 0xf, true)); }
__device__ __forceinline__ float sum8(float x) {
    x += dpp_f<0xB1>(x); x += dpp_f<0x4E>(x); x += dpp_f<0x141>(x); return x;
}
__device__ __forceinline__ float sum16(float x) {
    x += dpp_f<0x128>(x); x += dpp_f<0x124>(x); x += dpp_f<0x122>(x); x += dpp_f<0x121>(x); return x;
}

namespace pg8 {
constexpr int BM = 256, BK = 64, HALF = 128, HTB = HALF * BK * 2, STAGE_BYTES = 8 * HTB, NXCD = 8, WGM = 2;
__host__ __device__ __forceinline__ int lds_byte(int r, int c) { const int st = (r >> 4) * 2 + (c >> 5), rr = r & 15, cc = c & 31, ob = rr * 64 + cc * 2; return st * 1024 + (ob ^ (((ob >> 9) & 1) << 5)); }
__host__ __device__ __forceinline__ void stage_rc(int b, int& R, int& C) { const int st = b / 1024, sb = b % 1024, swz = sb ^ (((sb >> 9) & 1) << 5); R = (st >> 1) * 16 + swz / 64; C = (st & 1) * 32 + (swz % 64) / 2; }
__host__ __device__ __forceinline__ int perm32(int rho) { const int n = rho >> 4, i = rho & 15; return 8 * (i >> 2) + 4 * n + (i & 3); }

struct Unit { int pm, pn; };

struct TileOrder {
    int nM, nN, nwg, G, c;
    __device__ __forceinline__ void init(int nM_, int nN_, int G_, int c_) { nM = nM_; nN = nN_; nwg = nM * nN; G = G_; c = c_; }
    __device__ __forceinline__ bool next(int i, Unit& u) const {
        const long L = (long)i * G + c; if (L >= nwg) return false;
        int wgid = (int)L; { const int q = nwg / NXCD, r = nwg % NXCD, xcd = wgid % NXCD, off = wgid / NXCD; wgid = (xcd < r ? xcd * (q + 1) : r * (q + 1) + (xcd - r) * q) + off; }
        const int nig = WGM * nN, gid = wgid / nig, fm = gid * WGM, gsz = (nM - fm) < WGM ? (nM - fm) : WGM;
        u.pm = fm + ((wgid % nig) % gsz); u.pn = (wgid % nig) / gsz; return true;
    }
};

template <int LDK = 0, class Epi, class Sched>
__device__ __forceinline__ void gemm_phase(LAS unsigned char* lds, const int K, const Sched& S, const Epi& E) {
    const int ldk = LDK ? LDK : K;
    const int tid = threadIdx.x, wid = __builtin_amdgcn_readfirstlane(tid >> 6), lane = tid & 63, wr = wid >> 2, wc = wid & 3, fr = lane & 15, fq = lane >> 4;
    const int nt = K / BK;
    unsigned voffA[2], voffB[2];
#pragma unroll
    for (int i = 0; i < 2; ++i) { int R, C; stage_rc(tid * 16 + i * 8192, R, C); const int Rb = (R & ~31) + perm32(R & 31);
        voffA[i] = (unsigned)(R * ldk + C) * 2u; voffB[i] = (unsigned)(Rb * ldk + C) * 2u; }
    const size_t kstep = (size_t)(BK * 2);
    const size_t hstep = (size_t)HALF * ldk * 2;
    const unsigned ldsw = (unsigned)wid * 1024u;
    const int aoff = lds_byte(wr * 64 + fr, fq * 8), boff = lds_byte(wc * 32 + fr, fq * 8);
#define PG8_SA(b, h) (((b) * 2 + (h)) * HTB)
#define PG8_SB(b, h) ((4 + (b) * 2 + (h)) * HTB)
#define PG8_STAGE(bufoff, gbase, voff) do { _Pragma("unroll") for (int _i = 0; _i < 2; ++_i) \
        __builtin_amdgcn_global_load_lds((const unsigned*)((const char*)(gbase) + (voff)[_i]), (LAS unsigned*)(lds + (bufoff) + ldsw + _i * 8192), 16, 0, 0); } while (0)
#define PG8_LDA(dst, b, h) do { _Pragma("unroll") for (int m = 0; m < 4; ++m) _Pragma("unroll") for (int k = 0; k < 2; ++k) dst[m][k] = *(const LAS bf16x8*)(lds + PG8_SA(b, h) + aoff + m * 2048 + k * 1024); } while (0)
#define PG8_LDB(dst, b, h) do { _Pragma("unroll") for (int n = 0; n < 2; ++n) _Pragma("unroll") for (int k = 0; k < 2; ++k) dst[n][k] = *(const LAS bf16x8*)(lds + PG8_SB(b, h) + boff + n * 2048 + k * 1024); } while (0)
#define PG8_MMA(ai, bj, At, Bt) do { __builtin_amdgcn_s_setprio(1); _Pragma("unroll") for (int m = 0; m < 4; ++m) _Pragma("unroll") for (int n = 0; n < 2; ++n) _Pragma("unroll") for (int k = 0; k < 2; ++k) \
        acc[ai][bj][m][n] = __builtin_amdgcn_mfma_f32_16x16x32_bf16(Bt[n][k], At[m][k], acc[ai][bj][m][n], 0, 0, 0); __builtin_amdgcn_s_setprio(0); } while (0)
#define PG8_WAIT_V(n) asm volatile("s_waitcnt vmcnt(" #n ")" ::: "memory")
#define PG8_WAIT_L(n) asm volatile("s_waitcnt lgkmcnt(" #n ")" ::: "memory")
#define PG8_BAR __builtin_amdgcn_s_barrier()
#define PG8_SCHED __builtin_amdgcn_sched_barrier(0)
    Unit cur, nxt; int ui = 0;
    if (!S.next(0, cur)) return;
    f32x4 acc[2][2][4][2];
#pragma unroll
    for (int a = 0; a < 2; ++a)
#pragma unroll
        for (int b = 0; b < 2; ++b)
#pragma unroll
            for (int m = 0; m < 4; ++m)
#pragma unroll
                for (int n = 0; n < 2; ++n) acc[a][b][m][n] = (f32x4){0.f, 0.f, 0.f, 0.f};
    bf16x8 At[4][2], B0[2][2], B1[2][2];
    const char* cA = S.a_ptr(cur); const char* cB = S.b_ptr(cur);
    PG8_STAGE(PG8_SB(0, 0), cB, voffB); PG8_STAGE(PG8_SB(0, 1), cB + hstep, voffB); PG8_STAGE(PG8_SA(0, 0), cA, voffA); PG8_STAGE(PG8_SA(0, 1), cA + hstep, voffA);
    if (wr == 1) PG8_BAR;
    PG8_WAIT_V(2); PG8_BAR;
    PG8_STAGE(PG8_SB(1, 0), cB + kstep, voffB); PG8_STAGE(PG8_SA(1, 0), cA + kstep, voffA); PG8_STAGE(PG8_SB(1, 1), cB + hstep + kstep, voffB);
    PG8_WAIT_V(6); PG8_BAR;
    for (;;) {
        const bool has_next = S.next(ui + 1, nxt);
        const char* nA = has_next ? S.a_ptr(nxt) : cA; const char* nB = has_next ? S.b_ptr(nxt) : cB;
#pragma nounroll
        for (int t = 0; t < nt; t += 2) {
            const bool last = (t == nt - 2);
            const char* a1 = cA + (size_t)(t + 1) * kstep;
            const char* a2 = last ? nA : cA + (size_t)(t + 2) * kstep; const char* b2 = last ? nB : cB + (size_t)(t + 2) * kstep;
            const char* a3 = a2 + kstep; const char* b3 = b2 + kstep;
            PG8_LDB(B0, 0, 0); PG8_LDB(B1, 0, 1); PG8_SCHED; PG8_LDA(At, 0, 0); PG8_STAGE(PG8_SA(1, 1), a1 + hstep, voffA);
            PG8_WAIT_V(8); PG8_WAIT_L(0); PG8_BAR; PG8_MMA(0, 0, At, B0); PG8_MMA(0, 1, At, B1); PG8_BAR; PG8_SCHED;
            PG8_LDA(At, 0, 1); PG8_STAGE(PG8_SB(0, 0), b2, voffB); PG8_STAGE(PG8_SB(0, 1), b2 + hstep, voffB); PG8_STAGE(PG8_SA(0, 0), a2, voffA);
            PG8_WAIT_V(8); PG8_WAIT_L(0); PG8_BAR; PG8_MMA(1, 0, At, B0); PG8_MMA(1, 1, At, B1); PG8_BAR; PG8_SCHED;
            PG8_LDB(B0, 1, 0); PG8_LDB(B1, 1, 1); PG8_SCHED; PG8_LDA(At, 1, 0); PG8_STAGE(PG8_SA(0, 1), a2 + hstep, voffA);
            PG8_WAIT_V(8); PG8_WAIT_L(0); PG8_BAR; PG8_MMA(0, 0, At, B0); PG8_MMA(0, 1, At, B1); PG8_BAR; PG8_SCHED;
            PG8_LDA(At, 1, 1); PG8_STAGE(PG8_SB(1, 0), b3, voffB); PG8_STAGE(PG8_SB(1, 1), b3 + hstep, voffB); PG8_STAGE(PG8_SA(1, 0), a3, voffA);
            PG8_WAIT_V(8); PG8_WAIT_L(0); PG8_BAR; PG8_MMA(1, 0, At, B0); PG8_MMA(1, 1, At, B1); PG8_BAR; PG8_SCHED;
        }
        if (wr == 0) PG8_BAR;
        E(acc, cur, wr, wc, fr, fq);
        if (!has_next) break;
#pragma unroll
        for (int a = 0; a < 2; ++a)
#pragma unroll
            for (int b = 0; b < 2; ++b)
#pragma unroll
                for (int m = 0; m < 4; ++m)
#pragma unroll
                    for (int n = 0; n < 2; ++n) acc[a][b][m][n] = (f32x4){0.f, 0.f, 0.f, 0.f};
        cur = nxt; cA = nA; cB = nB; ++ui;
        if (wr == 1) PG8_BAR;
    }
    PG8_WAIT_V(0);
    PG8_BAR;
#undef PG8_SA
#undef PG8_SB
#undef PG8_STAGE
#undef PG8_LDA
#undef PG8_LDB
#undef PG8_MMA
#undef PG8_WAIT_V
#undef PG8_WAIT_L
#undef PG8_BAR
#undef PG8_SCHED
}
}

constexpr size_t MiB = 1u << 20;
constexpr size_t RB2 = (size_t)MP * 2048 * 2;
constexpr size_t RB1 = (size_t)MP * 1024 * 2;
constexpr size_t WS_CTL = 0, CTL_ZERO_BYTES = 64 * 1024;
constexpr size_t WS_STATS = 1 * MiB;
constexpr size_t WS_WIN = 2 * MiB;
constexpr size_t WS_WOUT = WS_WIN + 28 * MiB;
constexpr size_t WS_WGATE = WS_WOUT + 8 * MiB;
constexpr size_t WS_WR = WS_WGATE + 16 * MiB;
constexpr size_t WS_WPROJ = WS_WR + 40 * MiB;
constexpr size_t WS_WL1 = WS_WPROJ + 2 * MiB;
constexpr size_t WS_WL2 = WS_WL1 + 2 * MiB;
constexpr size_t WS_PB = WS_WL2 + 2 * MiB;
constexpr size_t WS_PP = WS_PB + 17 * MiB;
constexpr size_t WS_H = WS_PP + 65 * MiB;
constexpr size_t WS_HA = WS_H, WS_HB = WS_H + 65 * MiB;
constexpr size_t WS_T = WS_H + 130 * MiB;
constexpr size_t T_XN0 = WS_T, T_Q = T_XN0 + RB2, T_K = T_Q + RB1, T_V = T_K + RB1, T_GA = T_V + RB1, T_UB = T_GA + RB1, T_VB = T_UB + RB1, T_GB = T_VB + RB1, T_A2 = T_GB + RB1, T_HB0 = T_A2 + RB2;
constexpr size_t T_OP = WS_T + 430 * MiB;
constexpr size_t T_LSE = WS_T + 530 * MiB;
constexpr size_t T_XR = WS_T, T_XW = T_XR + RB2, T_XK = T_XW + RB2, T_XV = T_XK + RB2, T_XA = T_XV + RB2, T_XG = T_XA + RB2;
constexpr size_t T_EW = WS_T, T_AA = T_EW + RB2, T_YG = T_AA + RB2, T_HB1 = T_YG + RB2;
constexpr size_t T_R = T_XG + RB2, T_K2 = T_R + RB2, T_V2 = T_K2 + RB2, T_GG = T_V2 + RB2, T_HL = T_GG + RB2;
constexpr size_t WS_END = T_HL + (size_t)MP * 256 * 2;
static_assert(WS_END <= 1024 * MiB, "workspace map");

constexpr size_t O_YP = 0, O_YS = O_YP + (size_t)MPR * D, O_AKP = O_YS + (size_t)NS * D, O_AVP = O_AKP + (size_t)MPR * AW, O_AKS = O_AVP + (size_t)MPR * AW,
    O_AVS = O_AKS + (size_t)NS * AW, O_BVS = O_AVS + (size_t)NS * AW, O_WKVP = O_BVS + (size_t)NS * AW, O_SHP = O_WKVP + (size_t)NBATCH * NHC * HC * HC,
    O_WKVS = O_SHP + (size_t)NBATCH * D, O_SHS = O_WKVS + (size_t)NS * NHC * HC * HC, O_END = O_SHS + (size_t)NS * D;
static_assert(O_END == 72597504, "d_out layout");

constexpr int RING_BYTES = 140288, LDSCTL_OFF = RING_BYTES, MISC_OFF = LDSCTL_OFF + 320, LDS_TAB_OFF = RING_BYTES + 1024, LDS_BYTES = 147456;

#define XB_TMO      128
#define XB_XCNT(j)  (256  + 64 * (j))
#define XB_XSUB(j)  (1280 + 64 * (j))
#define XB_XGEN(j)  (2304 + 64 * (j))
#define XB_TOP      3328
#define XB_TOPGEN   3392
#define XCD_BAR_WORDS 3456
#define XB_SPIN_CAP (1u << 20)
__device__ __forceinline__ unsigned xb_ld(unsigned* p)              { return __hip_atomic_load(p, __ATOMIC_RELAXED, __HIP_MEMORY_SCOPE_AGENT); }
__device__ __forceinline__ unsigned xb_add(unsigned* p, unsigned v) { return __hip_atomic_fetch_add(p, v, __ATOMIC_RELAXED, __HIP_MEMORY_SCOPE_AGENT); }
__device__ __forceinline__ unsigned xb_xcc_id() { return (unsigned)__builtin_amdgcn_s_getreg((3 << 11) | 20) & 0xFu; }
#define XB_SPIN(cond, bar) do { unsigned _sp = 0; while (cond) { __builtin_amdgcn_s_sleep(1); \
    if ((++_sp & 255u) == 0u) { if (xb_ld(&(bar)[XB_TMO])) break; if (_sp > XB_SPIN_CAP) { atomicAdd(&(bar)[XB_TMO], 1u); break; } } } } while (0)
struct XcdBarrier { unsigned* bar; unsigned x; volatile LAS unsigned* st; };
__device__ __forceinline__ XcdBarrier xcd_barrier_post(unsigned* bar, volatile LAS unsigned* st) {
    XcdBarrier b; b.bar = bar; b.x = xb_xcc_id(); b.st = st;
    if (threadIdx.x == 0) (void)xb_add(&bar[XB_XCNT(b.x)], 1u);
    return b;
}
__device__ __forceinline__ void xcd_barrier_complete(unsigned* bar, unsigned x, unsigned& nloc, unsigned& nx) {
    const unsigned G = gridDim.x * gridDim.y * gridDim.z;
    unsigned sum, cnt, mine, sp = 0u;
    for (;;) {
        sum = 0u; cnt = 0u; mine = 0u;
#pragma unroll
        for (unsigned j = 0; j < 16; ++j) { const unsigned c = xb_ld(&bar[XB_XCNT(j)]); sum += c; cnt += (c > 0u) ? 1u : 0u; mine = (j == x) ? c : mine; }
        if (sum == G) break;
        __builtin_amdgcn_s_sleep(1);
        if ((++sp & 255u) == 0u) { if (xb_ld(&bar[XB_TMO])) break; if (sp > XB_SPIN_CAP) { atomicAdd(&bar[XB_TMO], 1u); break; } }
    }
    nloc = mine > 0u ? mine : 1u; nx = cnt > 0u ? cnt : 1u;
}
__device__ __forceinline__ void xcd_barrier(const XcdBarrier& b) {
    asm volatile("s_waitcnt vmcnt(0)" ::: "memory");
    __syncthreads();
    if (threadIdx.x == 0) {
        unsigned* bar = b.bar;
        __builtin_amdgcn_s_waitcnt(0);
        unsigned nloc = b.st[0], nx = b.st[1];
        if (nloc == 0u) { xcd_barrier_complete(bar, b.x, nloc, nx); b.st[0] = nloc; b.st[1] = nx; }
        const unsigned old = xb_add(&bar[XB_XSUB(b.x)], 1u);
        const unsigned gen = old / nloc;
        if (old + 1u == (gen + 1u) * nloc) {
            __builtin_amdgcn_fence(__ATOMIC_RELEASE, "agent");
            asm volatile("s_waitcnt vmcnt(0)" ::: "memory");
            const unsigned og = xb_add(&bar[XB_TOP], 1u);
            const unsigned tg = og / nx;
            if (og + 1u == (tg + 1u) * nx) xb_add(&bar[XB_TOPGEN], 1u);
            else XB_SPIN(xb_ld(&bar[XB_TOPGEN]) == tg, bar);
            __builtin_amdgcn_fence(__ATOMIC_ACQUIRE, "agent");
            xb_add(&bar[XB_XGEN(b.x)], 1u);
            asm volatile("s_waitcnt vmcnt(0)" ::: "memory");
        } else {
            XB_SPIN(xb_ld(&bar[XB_XGEN(b.x)]) == gen, bar);
            __builtin_amdgcn_fence(__ATOMIC_ACQUIRE, "agent");
            asm volatile("s_waitcnt vmcnt(0)" ::: "memory");
        }
    }
    __syncthreads();
}

struct Args {
    const float* in[36];
    float* out; unsigned char* ws;
    int ph_lo, ph_hi;
};
enum { I_XP = 0, I_XS, I_CK, I_CV, I_SWKV, I_SSH, I_PP, I_PS, I_NG, I_FNG, I_RELB, I_WIN, I_WOUT, I_BWS, I_BBS, I_BLNG, I_BLNB, I_MU, I_WR, I_WK, I_WV, I_WG, I_WO,
       I_W0, I_W1, I_W2, I_A0, I_A1, I_A2, I_KK, I_KA, I_RK, I_GNG, I_GNB, I_PROJ, I_GATE };

struct Frame {
    LAS unsigned char* lds;
    int tid, lane, wave, G, bid;
};

__device__ __forceinline__ void p0_transpose_item(const float* W, int K, int N, bf16_t* WT, LAS float* scr, int item, int lane) {
    const int nblk = N / 32, kb = item / nblk, nb = item % nblk, k0 = 64 * kb, n0 = 32 * nb;
#pragma unroll 8
    for (int i = 0; i < 32; ++i) { const int kk = 2 * i + (lane >> 5); scr[kk * 33 + (lane & 31)] = W[(size_t)(k0 + kk) * N + n0 + (lane & 31)]; }
    asm volatile("s_waitcnt lgkmcnt(0)" ::: "memory");
    const int c = lane & 7;
#pragma unroll
    for (int j = 0; j < 4; ++j) { const int n = (lane >> 3) + 8 * j; const LAS float* s = scr + (8 * c) * 33 + n;
        u32x4 o; o.x = pk2(s[0 * 33], s[1 * 33]); o.y = pk2(s[2 * 33], s[3 * 33]); o.z = pk2(s[4 * 33], s[5 * 33]); o.w = pk2(s[6 * 33], s[7 * 33]);
        *(u32x4*)(WT + (size_t)(n0 + n) * K + k0 + 8 * c) = o; }
    asm volatile("s_waitcnt lgkmcnt(0)" ::: "memory");
}
__device__ __forceinline__ void p0_transpose_item64(const float* W, int K, int N, bf16_t* WT, LAS float* scr, int item, int lane) {
    const int nblk = N / 64, kb = item / nblk, nb = item % nblk, k0 = 64 * kb, n0 = 64 * nb;
    f32x4 v[16];
#pragma unroll
    for (int i = 0; i < 16; ++i) v[i] = *(const f32x4*)(W + (size_t)(k0 + 4 * i + (lane >> 4)) * N + n0 + 4 * (lane & 15));
#pragma unroll
    for (int i = 0; i < 16; ++i) { LAS float* d = scr + (4 * i + (lane >> 4)) * 65 + 4 * (lane & 15); d[0] = v[i][0]; d[1] = v[i][1]; d[2] = v[i][2]; d[3] = v[i][3]; }
    asm volatile("s_waitcnt lgkmcnt(0)" ::: "memory");
    const int c = lane & 7;
#pragma unroll
    for (int jr = 0; jr < 8; ++jr) { const int n = (lane >> 3) + 8 * jr; const LAS float* sp = scr + (8 * c) * 65 + n;
        u32x4 o; o.x = pk2(sp[0 * 65], sp[1 * 65]); o.y = pk2(sp[2 * 65], sp[3 * 65]); o.z = pk2(sp[4 * 65], sp[5 * 65]); o.w = pk2(sp[6 * 65], sp[7 * 65]);
        *(u32x4*)(WT + (size_t)(n0 + n) * K + k0 + 8 * c) = o; }
    asm volatile("s_waitcnt lgkmcnt(0)" ::: "memory");
}
__device__ __forceinline__ void rms_row_to_bf16(const float* xrow, const float* g, bf16_t* orow, int lane) {
    const float* xr = xrow + 8 * lane; const float* gr = g + 8 * lane;
    f32x4 v[8]; float s = 0.f;
#pragma unroll
    for (int j = 0; j < 4; ++j) { v[2 * j] = *(const f32x4*)(xr + 512 * j); v[2 * j + 1] = *(const f32x4*)(xr + 512 * j + 4); }
#pragma unroll
    for (int j = 0; j < 8; ++j) s += (v[j].x * v[j].x + v[j].y * v[j].y) + (v[j].z * v[j].z + v[j].w * v[j].w);
    const float rs = 1.0f / sqrtf(wave_sum(s) * (1.f / D) + RMS_EPS);
#pragma unroll
    for (int j = 0; j < 4; ++j) { const f32x4 g0 = *(const f32x4*)(gr + 512 * j), g1 = *(const f32x4*)(gr + 512 * j + 4); const f32x4 o0 = v[2 * j] * rs * g0, o1 = v[2 * j + 1] * rs * g1;
        u32x4 w; w.x = cvt_pk_bf16(o0.x, o0.y); w.y = cvt_pk_bf16(o0.z, o0.w); w.z = cvt_pk_bf16(o1.x, o1.y); w.w = cvt_pk_bf16(o1.z, o1.w); *(u32x4*)(orow + 8 * lane + 512 * j) = w; }
}
__device__ __forceinline__ void phase_prologue(const Args& A, const Frame& F) {
    unsigned char* ws = A.ws;
    const int gw = F.bid * 8 + F.wave, NGW = F.G * 8;
    const long gt = (long)F.bid * 512 + F.tid, NGT = (long)F.G * 512;
    LAS float* scr = (LAS float*)(F.lds + F.wave * 17408);
    constexpr int I_IN = (D / 64) * (NIN / 64), I_SQ = (D / 64) * (D / 64), I_PJ = (PLE / 64) * (D / 64), I_L1 = (D / 64) * (96 / 32);
    constexpr int NITEMS = I_IN + 8 * I_SQ + 2 * I_PJ + 2 * I_L1;
    for (int it = gw; it < NITEMS; it += NGW) {
        int r = it;
        if (r < I_IN) { p0_transpose_item64(A.in[I_WIN], D, NIN, (bf16_t*)(ws + WS_WIN), scr, r, F.lane); continue; } r -= I_IN;
        if (r < I_SQ) { p0_transpose_item64(A.in[I_WOUT], D, D, (bf16_t*)(ws + WS_WOUT), scr, r, F.lane); continue; } r -= I_SQ;
        if (r < 2 * I_SQ) { const int l = r / I_SQ; p0_transpose_item64(A.in[I_GATE] + (size_t)l * D * D, D, D, (bf16_t*)(ws + WS_WGATE) + (size_t)l * D * D, scr, r % I_SQ, F.lane); continue; } r -= 2 * I_SQ;
        if (r < 5 * I_SQ) { const int l = r / I_SQ; p0_transpose_item64(A.in[I_WR + l], D, D, (bf16_t*)(ws + WS_WR) + (size_t)l * D * D, scr, r % I_SQ, F.lane); continue; } r -= 5 * I_SQ;
        if (r < 2 * I_PJ) { const int l = r / I_PJ; p0_transpose_item64(A.in[I_PROJ] + (size_t)l * PLE * D, PLE, D, (bf16_t*)(ws + WS_WPROJ) + (size_t)l * D * PLE, scr, r % I_PJ, F.lane); continue; } r -= 2 * I_PJ;
        { const int l = r / I_L1; p0_transpose_item(A.in[l ? I_A1 : I_W1], D, 96, (bf16_t*)(ws + WS_WL1) + (size_t)l * 256 * D, scr, r % I_L1, F.lane); }
    }
    { bf16_t* wl1 = (bf16_t*)(ws + WS_WL1);
      for (long i = gt; i < 2L * 160 * D; i += NGT) { const int l = (int)(i / (160 * D)); const long r = i % (160 * D); wl1[(size_t)l * 256 * D + 96 * D + r] = 0; }
      bf16_t* wl2 = (bf16_t*)(ws + WS_WL2);
      for (int it = gw; it < 128; it += NGW) { const int mtx = it >> 6, n0 = (it & 63) * 32; const float* src = A.in[mtx ? I_A2 : I_W2];
#pragma unroll 8
          for (int i = 0; i < 48; ++i) { const int kk = 2 * i + (F.lane >> 5); scr[kk * 33 + (F.lane & 31)] = src[(size_t)kk * D + n0 + (F.lane & 31)]; }
          asm volatile("s_waitcnt lgkmcnt(0)" ::: "memory");
          const int n = F.lane >> 1, hf = F.lane & 1;
          bf16_t* dst = wl2 + (size_t)(mtx * 2048 + n0 + n) * 256 + 128 * hf;
#pragma unroll
          for (int c = 0; c < 16; ++c) { u32x4 o = (u32x4){0u, 0u, 0u, 0u};
              if (hf == mtx && c < 12) { const LAS float* sp = scr + (8 * c) * 33 + n; o.x = pk2(sp[0 * 33], sp[1 * 33]); o.y = pk2(sp[2 * 33], sp[3 * 33]); o.z = pk2(sp[4 * 33], sp[5 * 33]); o.w = pk2(sp[6 * 33], sp[7 * 33]); }
              *(u32x4*)(dst + 8 * c) = o; }
          asm volatile("s_waitcnt lgkmcnt(0)" ::: "memory");
      } }
    { bf16_t* pb = (bf16_t*)(ws + WS_PB);
      for (long i0 = gt; i0 < 2L * MV * 64; i0 += 4 * NGT) {
          f32x4 v[4]; size_t dof[4]; bool ok[4];
#pragma unroll
          for (int k = 0; k < 4; ++k) { const long i = i0 + k * NGT; ok[k] = i < 2L * MV * 64; const long ic = ok[k] ? i : i0;
              const int l = (int)(ic / ((long)MV * 64)); const long r = ic % ((long)MV * 64); const int m = (int)(r >> 6), c4 = (int)(r & 63) * 4;
              const float* src = m < MPR ? A.in[I_PP] + ((size_t)l * MPR + m) * PLE + c4 : A.in[I_PS] + ((size_t)l * NS + (m - MPR)) * PLE + c4;
              v[k] = *(const f32x4*)src; dof[k] = ((size_t)l * MP + m) * PLE + c4; }
#pragma unroll
          for (int k = 0; k < 4; ++k) if (ok[k]) { u32x2 w; w.x = pk2(v[k].x, v[k].y); w.y = pk2(v[k].z, v[k].w); *(u32x2*)(pb + dof[k]) = w; }
      } }
    { bf16_t* xn = (bf16_t*)(ws + T_XN0);
      for (int m = gw; m < MV; m += NGW) { const float* xr = m < MPR ? A.in[I_XP] + (size_t)m * D : A.in[I_XS] + (size_t)(m - MPR) * D; rms_row_to_bf16(xr, A.in[I_NG], xn + (size_t)m * D, F.lane); } }
}

#define EPI_LOOP_BEGIN \
    _Pragma("unroll") for (int ai = 0; ai < 2; ++ai) _Pragma("unroll") for (int m = 0; m < 4; ++m) { const int row = u.pm * 256 + ai * 128 + wr * 64 + m * 16 + fr; \
    _Pragma("unroll") for (int bj = 0; bj < 2; ++bj) { const int lc = bj * 128 + wc * 32 + 8 * fq; f32x4 v0 = acc[ai][bj][m][0], v1 = acc[ai][bj][m][1];
#define EPI_LOOP_END } }
__device__ __forceinline__ u32x4 pack8(const f32x4& v0, const f32x4& v1) { u32x4 w; w.x = cvt_pk_bf16(v0[0], v0[1]); w.y = cvt_pk_bf16(v0[2], v0[3]); w.z = cvt_pk_bf16(v1[0], v1[1]); w.w = cvt_pk_bf16(v1[2], v1[3]); return w; }
template <class F> __device__ __forceinline__ void map8(f32x4& v0, f32x4& v1, F f) {
#pragma unroll
    for (int j = 0; j < 4; ++j) { v0[j] = f(v0[j]); v1[j] = f(v1[j]); }
}

struct SchedSimple : pg8::TileOrder {
    const char* A; const char* B; size_t tstep;
    __device__ __forceinline__ const char* a_ptr(const pg8::Unit& u) const { return A + (size_t)u.pm * tstep; }
    __device__ __forceinline__ const char* b_ptr(const pg8::Unit& u) const { return B + (size_t)u.pn * tstep; }
};

struct EpiG1 {
    unsigned char* ws; float* out;
    __device__ __forceinline__ void emit(int pn, int row, int lc, f32x4 v0, f32x4 v1) const {
        const int sec = pn >> 2, cb = (pn & 3) * 256; bf16_t* dst = (bf16_t*)(ws + T_Q + (size_t)sec * RB1) + (size_t)row * AW + cb + lc;
        if (sec == 0) { v0 = v0 * 0.08838834764831845f; v1 = v1 * 0.08838834764831845f; }
        else if (sec <= 2) { float* o = out + (sec == 1 ? O_AKS : O_AVS) + (size_t)(row - MPR) * AW + cb + lc; *(f32x4*)o = v0; *(f32x4*)(o + 4) = v1; }
        else if (sec == 3 || sec == 6) map8(v0, v1, [](float x) { return siluf_(x); });
        else map8(v0, v1, [](float x) { return gelu_tanh_(x); });
        *(u32x4*)dst = pack8(v0, v1);
    }
    __device__ __forceinline__ void operator()(const f32x4 (&acc)[2][2][4][2], const pg8::Unit& u, int wr, int wc, int fr, int fq) const {
        const int sec = u.pn >> 2, cb = (u.pn & 3) * 256;
        bf16_t* dst = (bf16_t*)(ws + T_Q + (size_t)sec * RB1);
        if (sec == 0) {
            EPI_LOOP_BEGIN v0 = v0 * 0.08838834764831845f; v1 = v1 * 0.08838834764831845f; *(u32x4*)(dst + (size_t)row * AW + cb + lc) = pack8(v0, v1); EPI_LOOP_END
        } else if (sec <= 2) {
            float* op = out + (sec == 1 ? O_AKP : O_AVP); float* os = out + (sec == 1 ? O_AKS : O_AVS);
            EPI_LOOP_BEGIN *(u32x4*)(dst + (size_t)row * AW + cb + lc) = pack8(v0, v1);
                if (row < MV) { float* o = row < MPR ? op + (size_t)row * AW + cb + lc : os + (size_t)(row - MPR) * AW + cb + lc; *(f32x4*)o = v0; *(f32x4*)(o + 4) = v1; } EPI_LOOP_END
        } else if (sec == 3 || sec == 6) {
            EPI_LOOP_BEGIN map8(v0, v1, [](float x) { return siluf_(x); }); *(u32x4*)(dst + (size_t)row * AW + cb + lc) = pack8(v0, v1); EPI_LOOP_END
        } else {
            EPI_LOOP_BEGIN map8(v0, v1, [](float x) { return gelu_tanh_(x); }); *(u32x4*)(dst + (size_t)row * AW + cb + lc) = pack8(v0, v1); EPI_LOOP_END
        }
    }
};
struct EpiBf16 {
    bf16_t* O; int ldc;
    __device__ __forceinline__ void emit(int pn, int row, int lc, f32x4 v0, f32x4 v1) const { *(u32x4*)(O + (size_t)row * ldc + pn * 256 + lc) = pack8(v0, v1); }
    __device__ __forceinline__ void operator()(const f32x4 (&acc)[2][2][4][2], const pg8::Unit& u, int wr, int wc, int fr, int fq) const {
        EPI_LOOP_BEGIN *(u32x4*)(O + (size_t)row * ldc + u.pn * 256 + lc) = pack8(v0, v1); EPI_LOOP_END
    }
};
__device__ __forceinline__ void add_bf8(f32x4& v0, f32x4& v1, const u32x4 h) { v0[0] += bflo(h.x); v0[1] += bfhi(h.x); v0[2] += bflo(h.y); v0[3] += bfhi(h.y); v1[0] += bflo(h.z); v1[1] += bfhi(h.z); v1[2] += bflo(h.w); v1[3] += bfhi(h.w); }
template <bool FIRST> struct EpiRes {
    const float* xp; const float* xs; const bf16_t* Hin; bf16_t* Hout;
    __device__ __forceinline__ void emit(int pn, int row, int lc, f32x4 v0, f32x4 v1) const {
        const int col = pn * 256 + lc;
        if (FIRST) { const float* bp = xs + (size_t)(row - MPR) * D + col; v0 = v0 + *(const f32x4*)bp; v1 = v1 + *(const f32x4*)(bp + 4); }
        else add_bf8(v0, v1, *(const u32x4*)(Hin + (size_t)row * D + col));
        *(u32x4*)(Hout + (size_t)row * D + col) = pack8(v0, v1);
    }
    __device__ __forceinline__ void operator()(const f32x4 (&acc)[2][2][4][2], const pg8::Unit& u, int wr, int wc, int fr, int fq) const {
        EPI_LOOP_BEGIN
            const int col = u.pn * 256 + lc;
            if (FIRST) { const float* bp = xp + (size_t)row * D + col; v0 = v0 + *(const f32x4*)bp; v1 = v1 + *(const f32x4*)(bp + 4); }
            else add_bf8(v0, v1, *(const u32x4*)(Hin + (size_t)row * D + col));
            *(u32x4*)(Hout + (size_t)row * D + col) = pack8(v0, v1);
        EPI_LOOP_END
    }
};
struct EpiGate {
    const bf16_t* Hin; bf16_t* Hout; const bf16_t* PP;
    __device__ __forceinline__ void one(int row, int col, f32x4 v0, f32x4 v1) const {
        const u32x4 pp = *(const u32x4*)(PP + (size_t)row * D + col), hh = *(const u32x4*)(Hin + (size_t)row * D + col);
        map8(v0, v1, [](float x) { return sigmoidf_(x); });
        v0[0] *= bflo(pp.x); v0[1] *= bfhi(pp.x); v0[2] *= bflo(pp.y); v0[3] *= bfhi(pp.y); v1[0] *= bflo(pp.z); v1[1] *= bfhi(pp.z); v1[2] *= bflo(pp.w); v1[3] *= bfhi(pp.w);
        add_bf8(v0, v1, hh);
        *(u32x4*)(Hout + (size_t)row * D + col) = pack8(v0, v1);
    }
    __device__ __forceinline__ void emit(int pn, int row, int lc, f32x4 v0, f32x4 v1) const { one(row, pn * 256 + lc, v0, v1); }
    __device__ __forceinline__ void operator()(const f32x4 (&acc)[2][2][4][2], const pg8::Unit& u, int wr, int wc, int fr, int fq) const {
        EPI_LOOP_BEGIN one(row, u.pn * 256 + lc, v0, v1); EPI_LOOP_END
    }
};
struct SchedG4 : pg8::TileOrder {
    unsigned char* ws;
    __device__ __forceinline__ const char* a_ptr(const pg8::Unit& u) const {
        const int g = u.pn >> 3; const size_t off = g == 0 ? T_XR : g == 1 ? T_XK : g == 2 ? T_XV : g == 3 ? T_XG : (u.pn == 32 ? T_XW : T_XA);
        return (const char*)ws + off + (size_t)u.pm * 256 * D * 2; }
    __device__ __forceinline__ const char* b_ptr(const pg8::Unit& u) const {
        const int g = u.pn >> 3;
        if (g < 4) { const int widx = g == 3 ? 3 : g;     return (const char*)ws + WS_WR + (size_t)widx * D * D * 2 + (size_t)(u.pn & 7) * 256 * D * 2; }
        return (const char*)ws + WS_WL1 + (size_t)(u.pn - 32) * 256 * D * 2; }
};
struct EpiG4 {
    unsigned char* ws;
    __device__ __forceinline__ void emit(int pn, int row, int lc, f32x4 v0, f32x4 v1) const {
        const int g = pn >> 3, cb = (pn & 7) * 256;
        if (g < 3) { *(u32x4*)((bf16_t*)(ws + T_R + (size_t)g * RB2) + (size_t)row * D + cb + lc) = pack8(v0, v1); }
        else if (g == 3) { map8(v0, v1, [](float x) { return siluf_(x); }); *(u32x4*)((bf16_t*)(ws + T_GG) + (size_t)row * D + cb + lc) = pack8(v0, v1); }
        else if (lc < 128) { if (pn == 32) map8(v0, v1, [](float x) { return tanhf_(x); }); *(u32x4*)((bf16_t*)(ws + T_HL) + (size_t)row * 256 + (pn == 32 ? 0 : 128) + lc) = pack8(v0, v1); }
    }
    __device__ __forceinline__ void operator()(const f32x4 (&acc)[2][2][4][2], const pg8::Unit& u, int wr, int wc, int fr, int fq) const {
        const int g = u.pn >> 3, cb = (u.pn & 7) * 256;
        if (g < 3) { bf16_t* dst = (bf16_t*)(ws + T_R + (size_t)g * RB2);
            EPI_LOOP_BEGIN *(u32x4*)(dst + (size_t)row * D + cb + lc) = pack8(v0, v1); EPI_LOOP_END
        } else if (g == 3) { bf16_t* dst = (bf16_t*)(ws + T_GG);
            EPI_LOOP_BEGIN map8(v0, v1, [](float x) { return siluf_(x); }); *(u32x4*)(dst + (size_t)row * D + cb + lc) = pack8(v0, v1); EPI_LOOP_END
        } else if (u.pn == 32) { bf16_t* dst = (bf16_t*)(ws + T_HL);
            EPI_LOOP_BEGIN if (bj == 0) { map8(v0, v1, [](float x) { return tanhf_(x); }); *(u32x4*)(dst + (size_t)row * 256 + lc) = pack8(v0, v1); } EPI_LOOP_END
        } else { bf16_t* dst = (bf16_t*)(ws + T_HL);
            EPI_LOOP_BEGIN if (bj == 0) { *(u32x4*)(dst + (size_t)row * 256 + 128 + lc) = pack8(v0, v1); } EPI_LOOP_END
        }
    }
};
struct SchedL2 : pg8::TileOrder {
    const char* A; const char* B;
    __device__ __forceinline__ const char* a_ptr(const pg8::Unit& u) const { return A + (size_t)u.pm * 256 * 256 * 2 + (u.pn >= 8 ? 256 : 0); }
    __device__ __forceinline__ const char* b_ptr(const pg8::Unit& u) const { return B + (size_t)u.pn * 256 * 256 * 2 + (u.pn >= 8 ? 256 : 0); }
};
struct EpiL2 {
    unsigned char* ws; const float* w0; const float* a0;
    __device__ __forceinline__ void emit(int pn, int row, int lc, f32x4 v0, f32x4 v1) const {
        const bool isw = pn < 8; const int col = (pn & 7) * 256 + lc; const float* bias = isw ? w0 : a0; const float sc = isw ? 0.6065306597126334f : 1.0f;
        v0 = v0 + *(const f32x4*)(bias + col); v1 = v1 + *(const f32x4*)(bias + col + 4); map8(v0, v1, [](float x) { return sigmoidf_(x); }); v0 = v0 * sc; v1 = v1 * sc;
        *(u32x4*)((bf16_t*)(ws + (isw ? T_EW : T_AA)) + (size_t)row * D + col) = pack8(v0, v1);
    }
    __device__ __forceinline__ void operator()(const f32x4 (&acc)[2][2][4][2], const pg8::Unit& u, int wr, int wc, int fr, int fq) const {
        const bool isw = u.pn < 8; const int cb = (u.pn & 7) * 256;
        bf16_t* dst = (bf16_t*)(ws + (isw ? T_EW : T_AA)); const float* bias = isw ? w0 : a0; const float sc = isw ? 0.6065306597126334f : 1.0f;
        EPI_LOOP_BEGIN
            const int col = cb + lc; const f32x4 b0 = *(const f32x4*)(bias + col), b1 = *(const f32x4*)(bias + col + 4);
            v0 = v0 + b0; v1 = v1 + b1; map8(v0, v1, [](float x) { return sigmoidf_(x); }); v0 = v0 * sc; v1 = v1 * sc;
            *(u32x4*)(dst + (size_t)row * D + col) = pack8(v0, v1);
        EPI_LOOP_END
    }
};


template <class Epi, class Sched>
__device__ __forceinline__ void skinny_gemm(const Frame& F, const int K, const int nN, const Sched& S, const Epi& E, const int first_idle = 0) {
    const int lane = F.lane, w = F.wave, fr = lane & 15, g = lane >> 4;
    LAS float* RED = (LAS float*)F.lds;
    const int kper = K / 8;
    const int nidle = F.G - first_idle;
    for (int u = F.bid - first_idle; u >= 0 && u < nN * 8; u += nidle) {
        pg8::Unit un; un.pm = MPR / 256; un.pn = u >> 3; const int lc0 = (u & 7) * 32;
        const bf16_t* Ab = (const bf16_t*)S.a_ptr(un) + (size_t)w * kper;
        const bf16_t* Bb = (const bf16_t*)S.b_ptr(un) + (size_t)lc0 * K + (size_t)w * kper;
        const bf16_t* b0 = Bb + (size_t)(8 * (fr >> 2) + (fr & 3)) * K + 8 * g; const bf16_t* b1 = b0 + (size_t)4 * K;
        const bf16_t* a0 = Ab + (size_t)fr * K + 8 * g; const bf16_t* a1 = a0 + (size_t)16 * K;
        f32x4 acc[2][2];
#pragma unroll
        for (int i = 0; i < 2; ++i) { acc[i][0] = (f32x4){0.f, 0.f, 0.f, 0.f}; acc[i][1] = acc[i][0]; }
        for (int k0 = 0; k0 < kper; k0 += 128) {
#pragma unroll
            for (int kk = 0; kk < 4; ++kk) { if (k0 + 32 * kk < kper) {
                const bf16x8 A0 = *(const bf16x8*)(a0 + k0 + 32 * kk), A1 = *(const bf16x8*)(a1 + k0 + 32 * kk), B0 = *(const bf16x8*)(b0 + k0 + 32 * kk), B1 = *(const bf16x8*)(b1 + k0 + 32 * kk);
                acc[0][0] = __builtin_amdgcn_mfma_f32_16x16x32_bf16(B0, A0, acc[0][0], 0, 0, 0); acc[0][1] = __builtin_amdgcn_mfma_f32_16x16x32_bf16(B1, A0, acc[0][1], 0, 0, 0);
                acc[1][0] = __builtin_amdgcn_mfma_f32_16x16x32_bf16(B0, A1, acc[1][0], 0, 0, 0); acc[1][1] = __builtin_amdgcn_mfma_f32_16x16x32_bf16(B1, A1, acc[1][1], 0, 0, 0); } }
        }
        __syncthreads();
#pragma unroll
        for (int i = 0; i < 2; ++i)
#pragma unroll
            for (int j = 0; j < 2; ++j) *(LAS f32x4*)(RED + ((w * 64 + lane) * 16 + (i * 2 + j) * 4)) = acc[i][j];
        __syncthreads();
        if (w < 2) {
            f32x4 v0 = (f32x4){0.f, 0.f, 0.f, 0.f}, v1 = v0;
#pragma unroll
            for (int ww = 0; ww < 8; ++ww) { v0 = v0 + *(const LAS f32x4*)(RED + ((ww * 64 + lane) * 16 + (w * 2 + 0) * 4)); v1 = v1 + *(const LAS f32x4*)(RED + ((ww * 64 + lane) * 16 + (w * 2 + 1) * 4)); }
            E.emit(un.pn, MPR + 16 * w + fr, lc0 + 8 * g, v0, v1);
        }
    }
    __syncthreads();
}

__device__ __forceinline__ int t5_bucket(int dist) {
    if (dist < 16) return dist;
    const float d = (float)dist;
    const int lb = 16 + (int)(logf(d / 16.0f) / 4.852030263919617f * 16.0f);
    return lb < 31 ? lb : 31;
}
__device__ __forceinline__ void phase_attn_naive(const Args& A, const Frame& F) {
    unsigned char* ws = A.ws;
    LAS float* QF = (LAS float*)F.lds; LAS float* SC = QF + 128; LAS float* RED = QF + 1024; LAS float* WR = QF + 640;
    const bf16_t* Qb = (const bf16_t*)(ws + T_Q); const bf16_t* Kb = (const bf16_t*)(ws + T_K); const bf16_t* Vb = (const bf16_t*)(ws + T_V); const bf16_t* GA = (const bf16_t*)(ws + T_GA);
    bf16_t* A2 = (bf16_t*)(ws + T_A2);
    const int gw = F.bid * 8 + F.wave, NGW = F.G * 8, lane = F.lane, tid = F.tid;
    for (int item = F.bid; item < NS * 8; item += F.G) {
        const int b = item >> 3, h = item & 7, m = MPR + b;
        __syncthreads();
        if (tid < 128) QF[tid] = bf1(Qb[(size_t)m * AW + h * 128 + tid]);
        __syncthreads();
        const int uu = tid, p = uu / 129, s = uu - p * 129, dil = p == 0 ? 1 : p == 1 ? 4 : 16; const bool valid = uu < 387;
        float sc = -1e30f;
        if (valid) { float dot = 0.f;
            if (s == 0) { const u32x4* kr = (const u32x4*)(Kb + (size_t)m * AW + h * 128);
#pragma unroll
                for (int c = 0; c < 16; ++c) { const u32x4 kv = kr[c]; const f32x4 qa = *(const LAS f32x4*)(QF + 8 * c), qb = *(const LAS f32x4*)(QF + 8 * c + 4);
                    dot += qa[0] * bflo(kv.x) + qa[1] * bfhi(kv.x) + qa[2] * bflo(kv.y) + qa[3] * bfhi(kv.y) + qb[0] * bflo(kv.z) + qb[1] * bfhi(kv.z) + qb[2] * bflo(kv.w) + qb[3] * bfhi(kv.w); }
            } else { const f32x4* kr = (const f32x4*)(A.in[I_CK] + (((size_t)b * 2048 + (2048 - s * dil)) * 8 + h) * 128);
#pragma unroll
                for (int c = 0; c < 32; ++c) { const f32x4 kv = kr[c]; const f32x4 qa = *(const LAS f32x4*)(QF + 4 * c); dot += qa[0] * kv[0] + qa[1] * kv[1] + qa[2] * kv[2] + qa[3] * kv[3]; } }
            sc = dot + A.in[I_RELB][t5_bucket(s * dil) * 8 + h]; }
        float mx = wave_max(sc); if (lane == 0) WR[F.wave] = mx;
        __syncthreads();
        mx = fmaxf(fmaxf(fmaxf(WR[0], WR[1]), fmaxf(WR[2], WR[3])), fmaxf(fmaxf(WR[4], WR[5]), fmaxf(WR[6], WR[7])));
        const float pv = valid ? fast_exp(sc - mx) : 0.f; if (tid < 392) SC[tid] = pv;
        const float ls = wave_sum(pv); if (lane == 0) WR[8 + F.wave] = ls;
        __syncthreads();
        const float l = ((WR[8] + WR[9]) + (WR[10] + WR[11])) + ((WR[12] + WR[13]) + (WR[14] + WR[15]));
        const int kg = tid >> 5, e4 = (tid & 31) * 4; f32x4 acc = (f32x4){0.f, 0.f, 0.f, 0.f};
        {
            f32x4 vv[25]; float pw[25];
#pragma unroll
            for (int it = 0; it < 25; ++it) { const int u2 = kg + 16 * it; const bool ok = u2 < 387; const int uc = ok ? u2 : 386; const int p2 = uc / 129, s2 = uc - p2 * 129, d2 = p2 == 0 ? 1 : p2 == 1 ? 4 : 16;
                pw[it] = ok ? SC[uc] : 0.f;
                if (s2 == 0) { const u32x2 v2 = *(const u32x2*)(Vb + (size_t)m * AW + h * 128 + e4); vv[it] = (f32x4){bflo(v2.x), bfhi(v2.x), bflo(v2.y), bfhi(v2.y)}; }
                else vv[it] = *(const f32x4*)(A.in[I_CV] + (((size_t)b * 2048 + (2048 - s2 * d2)) * 8 + h) * 128 + e4); }
#pragma unroll
            for (int it = 0; it < 25; ++it) acc = acc + vv[it] * pw[it];
        }
        *(LAS f32x4*)(RED + kg * 128 + e4) = acc;
        __syncthreads();
        if (tid < 128) { float o = 0.f;
#pragma unroll
            for (int q = 0; q < 16; ++q) o += RED[q * 128 + tid];
            A2[(size_t)m * D + h * 128 + tid] = (bf16_t)f2bf(o / l * bf1(GA[(size_t)m * AW + h * 128 + tid])); }
    }
    __syncthreads();
    const bf16_t* VBb = (const bf16_t*)(ws + T_VB); const bf16_t* UB = (const bf16_t*)(ws + T_UB); const bf16_t* GB = (const bf16_t*)(ws + T_GB);
    float* ST = (float*)(ws + WS_STATS);
    for (int m = gw; m < MV; m += NGW) {
        const u32x4 a = *(const u32x4*)(VBb + (size_t)m * AW + 8 * lane), c = *(const u32x4*)(VBb + (size_t)m * AW + 512 + 8 * lane);
        float x[16] = {bflo(a.x), bfhi(a.x), bflo(a.y), bfhi(a.y), bflo(a.z), bfhi(a.z), bflo(a.w), bfhi(a.w), bflo(c.x), bfhi(c.x), bflo(c.y), bfhi(c.y), bflo(c.z), bfhi(c.z), bflo(c.w), bfhi(c.w)};
        float s = 0.f;
#pragma unroll
        for (int j = 0; j < 16; ++j) s += x[j];
        const float mean = wave_sum(s) * (1.f / AW); float q = 0.f;
#pragma unroll
        for (int j = 0; j < 16; ++j) { const float d = x[j] - mean; q += d * d; }
        const float rstd = 1.0f / sqrtf(wave_sum(q) * (1.f / AW) + LN_EPS);
        if (lane == 0) { ST[2 * m] = mean; ST[2 * m + 1] = rstd; }
        if (m >= MPR) { const int bs = m - MPR;
#pragma unroll
            for (int j = 0; j < 16; ++j) { const int col = (j < 8 ? 0 : 512) + 8 * lane + (j & 7); const int g = col >> 7;
                const float vn = (x[j] - mean) * rstd * A.in[I_BLNG][col] + A.in[I_BLNB][col];
                A.out[O_BVS + (size_t)bs * AW + col] = vn;
                const float sb = A.in[I_BWS][(size_t)g * 128 * 128] * vn + A.in[I_BBS][g * 128];
                const float ob = bf1(UB[(size_t)m * AW + col]) * sb * bf1(GB[(size_t)m * AW + col]);
                A2[(size_t)m * D + AW + col] = (bf16_t)f2bf(ob); } }
    }
}


typedef short s16x4 __attribute__((ext_vector_type(4)));
__device__ __forceinline__ s16x4 lds_tr16(unsigned byte_addr) { return __builtin_bit_cast(s16x4, __builtin_amdgcn_ds_read_tr16_b64_v4i16((LAS s16x4*)(size_t)byte_addr)); }
__device__ __forceinline__ unsigned koff_sw(int key, int c) { return (unsigned)(key * 256 + ((c ^ (key & 15)) << 4)); }
__device__ __forceinline__ unsigned voff_sw(int key, int c) { return (unsigned)(key * 256 + ((((c >> 1) ^ (key & 7)) << 5) | ((c & 1) << 4))); }
__device__ __forceinline__ void attn_stage(const Frame& F, const bf16_t* Kb, const bf16_t* Vb, int slot, int b, int h, int r, int d, int nsub) {
#pragma unroll
    for (int i = 0; i < 4; ++i) { const int idx = F.tid + 512 * i, kk = idx >> 4, c = idx & 15; const int t = (128 * nsub + kk) * d + r;
        const size_t g = ((size_t)(b * SEQ + t)) * AW + h * 128 + 8 * c;
        const u32x4 kv = *(const u32x4*)(Kb + g), vv = *(const u32x4*)(Vb + g);
        *(LAS u32x4*)(F.lds + slot * 32768 + koff_sw(kk, c)) = kv; *(LAS u32x4*)(F.lds + 65536 + slot * 32768 + voff_sw(kk, c)) = vv; }
}
__device__ __forceinline__ void phase_attn(const Args& A, const Frame& F) {
    unsigned char* ws = A.ws;
    const bf16_t* Qb = (const bf16_t*)(ws + T_Q); const bf16_t* Kb = (const bf16_t*)(ws + T_K); const bf16_t* Vb = (const bf16_t*)(ws + T_V);
    bf16_t* OP = (bf16_t*)(ws + T_OP); float* LSE = (float*)(ws + T_LSE);
    LAS float* T3 = (LAS float*)(F.lds + LDS_TAB_OFF);
    const int lane = F.lane, w = F.wave, ql = lane & 15, g = lane >> 4;
    const int nfb = F.G == 256 ? 12 : 0;
    u32x4 RK[4], RV[4]; bf16x8 RQ[4];
#define ATT_DESC(fb, p_, b_, h_, d_, r_, n_) const int q96_##p_ = (F.bid >> 3) + 32 * ((fb) >> 2), k_##p_ = (fb) & 3, p_ = (q96_##p_ % 12) >> 2, qi_##p_ = ((F.bid & 7) * 8 + q96_##p_ / 12) * 4 + (q96_##p_ & 3), b_ = qi_##p_ >> 5, h_ = (qi_##p_ >> 2) & 7, \
        d_ = p_ == 0 ? 1 : p_ == 1 ? 4 : 16, r_ = p_ == 0 ? 0 : p_ == 1 ? (qi_##p_ & 3) : (qi_##p_ & 3) * 4 + k_##p_, n_ = p_ == 0 ? (qi_##p_ & 3) * 4 + k_##p_ : p_ == 1 ? k_##p_ : 0
#define ATT_LOAD(b_, h_, d_, r_, n_) do { _Pragma("unroll") for (int i_ = 0; i_ < 4; ++i_) { const int idx_ = F.tid + 512 * i_, kk_ = idx_ >> 4, c_ = idx_ & 15; \
            const size_t g_ = ((size_t)((b_) * SEQ + (128 * (n_) + kk_) * (d_) + (r_))) * AW + (h_) * 128 + 8 * c_; RK[i_] = *(const u32x4*)(Kb + g_); RV[i_] = *(const u32x4*)(Vb + g_); } \
        const size_t mq_ = (size_t)((b_) * SEQ + (128 * (n_) + 16 * w + ql) * (d_) + (r_)); \
        _Pragma("unroll") for (int ks_ = 0; ks_ < 4; ++ks_) RQ[ks_] = *(const bf16x8*)(Qb + mq_ * AW + (h_) * 128 + 32 * ks_ + 8 * g); } while (0)
    if (nfb > 0) { ATT_DESC(0, p0, b0, h0, d0, r0, n0); ATT_LOAD(b0, h0, d0, r0, n0); }
    for (int fb = 0; fb < nfb; ++fb) {
        ATT_DESC(fb, p, b, h, d, r, n); const int k = fb & 3;
        {
            const bool has_prev = n > 0; const int so = n & 1, sp = so ^ 1;
            __syncthreads();
#pragma unroll
            for (int i = 0; i < 4; ++i) { const int idx = F.tid + 512 * i, kk = idx >> 4, c = idx & 15;
                *(LAS u32x4*)(F.lds + so * 32768 + koff_sw(kk, c)) = RK[i]; *(LAS u32x4*)(F.lds + 65536 + so * 32768 + voff_sw(kk, c)) = RV[i]; }
            bf16x8 qf[4];
#pragma unroll
            for (int ks = 0; ks < 4; ++ks) qf[ks] = RQ[ks];
            if (k == 0) {
                if (F.tid < 384) { const int steps = 255 - F.tid; T3[F.tid] = (steps >= 0 && steps <= 128) ? A.in[I_RELB][t5_bucket(steps * d) * 8 + h] : -1e30f; }
                if (has_prev) attn_stage(F, Kb, Vb, sp, b, h, r, d, n - 1);
            }
            __syncthreads();
            if (fb + 1 < nfb) { ATT_DESC(fb + 1, pn, bn, hn, dn, rn, nn); ATT_LOAD(bn, hn, dn, rn, nn); }
            const size_t mq = (size_t)(b * SEQ + (128 * n + 16 * w + ql) * d + r);
            f32x4 sc[9]; const int zb = 127 - ql + 4 * g; float mx = -1e30f;
#pragma unroll
            for (int tt = 0; tt < 9; ++tt) {
                const int jt = w + tt; const bool tv = has_prev || jt >= 8;
                f32x4 acc = (f32x4){0.f, 0.f, 0.f, 0.f};
                if (tv) { const unsigned kb = (unsigned)((jt < 8 ? sp : so) * 32768); const int key = ((16 * jt) & 127) + ql;
#pragma unroll
                    for (int ks = 0; ks < 4; ++ks) { const bf16x8 a = *(const LAS bf16x8*)(F.lds + kb + koff_sw(key, 4 * ks + g)); acc = __builtin_amdgcn_mfma_f32_16x16x32_bf16(a, qf[ks], acc, 0, 0, 0); } }
#pragma unroll
                for (int rr = 0; rr < 4; ++rr) { const float sv = tv ? acc[rr] + T3[zb + 16 * tt + rr] : -1e30f; sc[tt][rr] = sv; mx = fmaxf(mx, sv); }
            }
            mx = fmaxf(mx, __shfl_xor(mx, 16)); mx = fmaxf(mx, __shfl_xor(mx, 32));
            float l = 0.f;
#pragma unroll
            for (int tt = 0; tt < 9; ++tt)
#pragma unroll
                for (int rr = 0; rr < 4; ++rr) { const float pv = fast_exp(sc[tt][rr] - mx); sc[tt][rr] = pv; l += pv; }
            l += __shfl_xor(l, 16); l += __shfl_xor(l, 32);
            f32x4 o[8];
#pragma unroll
            for (int et = 0; et < 8; ++et) o[et] = (f32x4){0.f, 0.f, 0.f, 0.f};
            const int qq = ql >> 2, pp = ql & 3;
#pragma unroll
            for (int kk = 0; kk < 5; ++kk) {
                const int t0 = 2 * kk, t1 = 2 * kk + 1;
                u32x4 pw; pw.x = cvt_pk_bf16(sc[t0][0], sc[t0][1]); pw.y = cvt_pk_bf16(sc[t0][2], sc[t0][3]);
                if (t1 < 9) { pw.z = cvt_pk_bf16(sc[t1 < 9 ? t1 : 8][0], sc[t1 < 9 ? t1 : 8][1]); pw.w = cvt_pk_bf16(sc[t1 < 9 ? t1 : 8][2], sc[t1 < 9 ? t1 : 8][3]); } else { pw.z = 0u; pw.w = 0u; }
                const bf16x8 pf = __builtin_bit_cast(bf16x8, pw);
                const int j0 = w + t0, j1 = t1 < 9 ? w + t1 : w + 8;
                const bool v0 = has_prev || j0 >= 8, v1 = has_prev || j1 >= 8;
                const int e0 = v0 ? j0 : 8 + (j0 & 7), e1 = v1 ? j1 : 8 + (j1 & 7);
                const unsigned vb0 = 65536u + (unsigned)((e0 < 8 ? sp : so) * 32768), vb1 = 65536u + (unsigned)((e1 < 8 ? sp : so) * 32768);
                const int key0 = ((16 * e0) & 127) + 4 * g + qq, key1 = ((16 * e1) & 127) + 4 * g + qq;
#pragma unroll
                for (int et = 0; et < 8; ++et) {
                    const s16x4 lo = lds_tr16((unsigned)(size_t)F.lds + vb0 + voff_sw(key0, 2 * et + (pp >> 1)) + 8 * (pp & 1));
                    const s16x4 hi = lds_tr16((unsigned)(size_t)F.lds + vb1 + voff_sw(key1, 2 * et + (pp >> 1)) + 8 * (pp & 1));
                    const bf16x8 af = __builtin_shufflevector(lo, hi, 0, 1, 2, 3, 4, 5, 6, 7);
                    o[et] = __builtin_amdgcn_mfma_f32_16x16x32_bf16(af, pf, o[et], 0, 0, 0);
                }
            }
            const float il = 1.0f / l;
            bf16_t* orow = OP + (size_t)p * MP * AW + mq * AW + h * 128 + 4 * g;
#pragma unroll
            for (int et = 0; et < 8; ++et) { u32x2 wv; wv.x = cvt_pk_bf16(o[et][0] * il, o[et][1] * il); wv.y = cvt_pk_bf16(o[et][2] * il, o[et][3] * il); *(u32x2*)(orow + 16 * et) = wv; }
            if (g == 0) LSE[((size_t)p * MP + mq) * 8 + h] = mx + logf(l);
        }
    }
#undef ATT_DESC
#undef ATT_LOAD
}

__device__ __forceinline__ void phase_bmix_naive(const Args& A, const Frame& F) {
    unsigned char* ws = A.ws;
    LAS float* VN = (LAS float*)F.lds; LAS float* WL = VN + 128 * 128;
    const bf16_t* VBb = (const bf16_t*)(ws + T_VB); const bf16_t* UB = (const bf16_t*)(ws + T_UB); const bf16_t* GB = (const bf16_t*)(ws + T_GB);
    const float* ST = (const float*)(ws + WS_STATS); bf16_t* A2 = (bf16_t*)(ws + T_A2);
    for (int unit = F.bid; unit < NBATCH * 16 * 8; unit += F.G) {
        const int g = unit & 7, n = (unit >> 3) & 15, b = unit >> 7; const int m0 = b * SEQ + n * 128;
        __syncthreads();
        for (int i = F.tid; i < 128 * 128; i += 512) { const int j = i >> 7, c = i & 127; const int col = g * 128 + c;
            const float x = bf1(VBb[(size_t)(m0 + j) * AW + col]);
            VN[i] = (x - ST[2 * (m0 + j)]) * ST[2 * (m0 + j) + 1] * A.in[I_BLNG][col] + A.in[I_BLNB][col];
            WL[i] = A.in[I_BWS][(size_t)g * 128 * 128 + i]; }
        __syncthreads();
        const int c = F.tid & 127, iq = F.tid >> 7;
        for (int ii = 0; ii < 32; ++ii) { const int i = iq + 4 * ii; float s = 0.f;
            for (int j = 0; j <= i; ++j) s += WL[i * 128 + j] * VN[j * 128 + c];
            s += A.in[I_BBS][g * 128 + i];
            const size_t o = (size_t)(m0 + i) * AW + g * 128 + c;
            A2[(size_t)(m0 + i) * D + AW + g * 128 + c] = (bf16_t)f2bf(bf1(UB[o]) * s * bf1(GB[o])); }
    }
}


__device__ __forceinline__ void phase_merge_bmix(const Args& A, const Frame& F) {
    unsigned char* ws = A.ws;
    bf16_t* A2 = (bf16_t*)(ws + T_A2);
    {
        const bf16_t* OP = (const bf16_t*)(ws + T_OP); const float* LSE = (const float*)(ws + T_LSE); const bf16_t* GA = (const bf16_t*)(ws + T_GA);
        const long gt = (long)F.bid * 512 + F.tid, NGT = (long)F.G * 512;
        for (long i0 = gt; i0 < (long)MPR * 128; i0 += 2 * NGT) {
            u32x4 qa[2], qb[2], qc[2], qg[2]; float l0[2], l1[2], l2[2];
#pragma unroll
            for (int k = 0; k < 2; ++k) { const long i = i0 + k * NGT; const int m = (int)(i >> 7), c = (int)(i & 127), h = c >> 4; const size_t off = (size_t)m * AW + 8 * c;
                l0[k] = LSE[((size_t)0 * MP + m) * 8 + h]; l1[k] = LSE[((size_t)1 * MP + m) * 8 + h]; l2[k] = LSE[((size_t)2 * MP + m) * 8 + h];
                qa[k] = *(const u32x4*)(OP + off); qb[k] = *(const u32x4*)(OP + (size_t)MP * AW + off); qc[k] = *(const u32x4*)(OP + (size_t)2 * MP * AW + off); qg[k] = *(const u32x4*)(GA + off); }
#pragma unroll
            for (int k = 0; k < 2; ++k) { const long i = i0 + k * NGT; const int m = (int)(i >> 7), c = (int)(i & 127);
                const float mx = fmaxf(l0[k], fmaxf(l1[k], l2[k])); float w0 = fast_exp(l0[k] - mx), w1 = fast_exp(l1[k] - mx), w2 = fast_exp(l2[k] - mx); const float iw = 1.0f / (w0 + w1 + w2); w0 *= iw; w1 *= iw; w2 *= iw;
                const u32x4 a = qa[k], bq = qb[k], cq = qc[k], gg = qg[k];
                u32x4 o;
                o.x = pk2((w0 * bflo(a.x) + w1 * bflo(bq.x) + w2 * bflo(cq.x)) * bflo(gg.x), (w0 * bfhi(a.x) + w1 * bfhi(bq.x) + w2 * bfhi(cq.x)) * bfhi(gg.x));
                o.y = pk2((w0 * bflo(a.y) + w1 * bflo(bq.y) + w2 * bflo(cq.y)) * bflo(gg.y), (w0 * bfhi(a.y) + w1 * bfhi(bq.y) + w2 * bfhi(cq.y)) * bfhi(gg.y));
                o.z = pk2((w0 * bflo(a.z) + w1 * bflo(bq.z) + w2 * bflo(cq.z)) * bflo(gg.z), (w0 * bfhi(a.z) + w1 * bfhi(bq.z) + w2 * bfhi(cq.z)) * bfhi(gg.z));
                o.w = pk2((w0 * bflo(a.w) + w1 * bflo(bq.w) + w2 * bflo(cq.w)) * bflo(gg.w), (w0 * bfhi(a.w) + w1 * bfhi(bq.w) + w2 * bfhi(cq.w)) * bfhi(gg.w));
                *(u32x4*)(A2 + (size_t)m * D + 8 * c) = o; }
        }
    }
    const bf16_t* VBb = (const bf16_t*)(ws + T_VB); const bf16_t* UB = (const bf16_t*)(ws + T_UB); const bf16_t* GB = (const bf16_t*)(ws + T_GB); const float* ST = (const float*)(ws + WS_STATS);
    const int lane = F.lane, w = F.wave, ql = lane & 15, gq = lane >> 4, qq = ql >> 2, pp = ql & 3;
    u32x4 px[4]; float pmean[4], prstd[4];
#define BMIX_FETCH(unit_) do { const int gch_ = (unit_) & 7, m0_ = ((unit_) >> 7) * SEQ + (((unit_) >> 3) & 15) * 128; \
        _Pragma("unroll") for (int i_ = 0; i_ < 4; ++i_) { const int idx_ = F.tid + 512 * i_, j_ = idx_ >> 4, c_ = idx_ & 15; \
            px[i_] = *(const u32x4*)(VBb + (size_t)(m0_ + j_) * AW + gch_ * 128 + 8 * c_); pmean[i_] = ST[2 * (m0_ + j_)]; prstd[i_] = ST[2 * (m0_ + j_) + 1]; } } while (0)
    if (F.bid < NBATCH * 16 * 8) BMIX_FETCH(F.bid);
    for (int unit = F.bid; unit < NBATCH * 16 * 8; unit += F.G) {
        const int gch = unit & 7, n = (unit >> 3) & 15, b = unit >> 7; const int m0 = b * SEQ + n * 128;
        __syncthreads();
#pragma unroll
        for (int i = 0; i < 4; ++i) { const int idx = F.tid + 512 * i, j = idx >> 4, c = idx & 15; const int col = gch * 128 + 8 * c;
            const u32x4 x = px[i]; const float mean = pmean[i], rstd = prstd[i];
            const f32x4 ga = *(const f32x4*)(A.in[I_BLNG] + col), gb = *(const f32x4*)(A.in[I_BLNG] + col + 4), ba = *(const f32x4*)(A.in[I_BLNB] + col), bb = *(const f32x4*)(A.in[I_BLNB] + col + 4);
            u32x4 o;
            o.x = pk2((bflo(x.x) - mean) * rstd * ga[0] + ba[0], (bfhi(x.x) - mean) * rstd * ga[1] + ba[1]); o.y = pk2((bflo(x.y) - mean) * rstd * ga[2] + ba[2], (bfhi(x.y) - mean) * rstd * ga[3] + ba[3]);
            o.z = pk2((bflo(x.z) - mean) * rstd * gb[0] + bb[0], (bfhi(x.z) - mean) * rstd * gb[1] + bb[1]); o.w = pk2((bflo(x.w) - mean) * rstd * gb[2] + bb[2], (bfhi(x.w) - mean) * rstd * gb[3] + bb[3]);
            *(LAS u32x4*)(F.lds + voff_sw(j, c)) = o; }
        __syncthreads();
        if (unit + F.G < NBATCH * 16 * 8) BMIX_FETCH(unit + F.G);
        const int i = 16 * w + ql, kmax = (16 * w + 15) >> 5;
        u32x2 pu[8], pg[8];
#pragma unroll
        for (int ct = 0; ct < 8; ++ct) { const size_t o = (size_t)(m0 + i) * AW + gch * 128 + 16 * ct + 4 * gq; pu[ct] = *(const u32x2*)(UB + o); pg[ct] = *(const u32x2*)(GB + o); }
        f32x4 acc[8];
#pragma unroll
        for (int ct = 0; ct < 8; ++ct) acc[ct] = (f32x4){0.f, 0.f, 0.f, 0.f};
        const float* Wrow = A.in[I_BWS] + ((size_t)gch * 128 + i) * 128;
        for (int ks = 0; ks <= kmax; ++ks) {
            const int ja = 32 * ks + 4 * gq, jb = ja + 16;
            f32x4 wa = *(const f32x4*)(Wrow + ja), wb = *(const f32x4*)(Wrow + jb);
#pragma unroll
            for (int e = 0; e < 4; ++e) { if (ja + e > i) wa[e] = 0.f; if (jb + e > i) wb[e] = 0.f; }
            u32x4 pw; pw.x = cvt_pk_bf16(wa[0], wa[1]); pw.y = cvt_pk_bf16(wa[2], wa[3]); pw.z = cvt_pk_bf16(wb[0], wb[1]); pw.w = cvt_pk_bf16(wb[2], wb[3]);
            const bf16x8 bf = __builtin_bit_cast(bf16x8, pw);
            const int ra = 32 * ks + 4 * gq + qq, rb = ra + 16;
#pragma unroll
            for (int ct = 0; ct < 8; ++ct) {
                const s16x4 lo = lds_tr16((unsigned)(size_t)F.lds + voff_sw(ra, 2 * ct + (pp >> 1)) + 8 * (pp & 1));
                const s16x4 hi = lds_tr16((unsigned)(size_t)F.lds + voff_sw(rb, 2 * ct + (pp >> 1)) + 8 * (pp & 1));
                const bf16x8 af = __builtin_shufflevector(lo, hi, 0, 1, 2, 3, 4, 5, 6, 7);
                acc[ct] = __builtin_amdgcn_mfma_f32_16x16x32_bf16(af, bf, acc[ct], 0, 0, 0);
            }
        }
        const float bias = A.in[I_BBS][gch * 128 + i];
#pragma unroll
        for (int ct = 0; ct < 8; ++ct) { const int col = gch * 128 + 16 * ct + 4 * gq;
            const u32x2 u2 = pu[ct], g2 = pg[ct];
            u32x2 wv; wv.x = pk2(bflo(u2.x) * (acc[ct][0] + bias) * bflo(g2.x), bfhi(u2.x) * (acc[ct][1] + bias) * bfhi(g2.x));
            wv.y = pk2(bflo(u2.y) * (acc[ct][2] + bias) * bflo(g2.y), bfhi(u2.y) * (acc[ct][3] + bias) * bfhi(g2.y));
            *(u32x2*)(A2 + (size_t)(m0 + i) * D + AW + col) = wv; }
    }
#undef BMIX_FETCH
}

__device__ __forceinline__ void phase_rms_mix(const Args& A, const Frame& F) {
    unsigned char* ws = A.ws; const bf16_t* H = (const bf16_t*)(ws + WS_HB);
    LAS float* G1 = (LAS float*)F.lds; LAS float* MU = G1 + D;
    for (int i = F.tid; i < D / 4; i += 512) ((LAS f32x4*)G1)[i] = ((const f32x4*)(A.in[I_NG] + D))[i];
    for (int i = F.tid; i < 6 * D / 4; i += 512) ((LAS f32x4*)MU)[i] = ((const f32x4*)A.in[I_MU])[i];
    __syncthreads();
    const int gw = F.bid * 8 + F.wave, NGW = F.G * 8, lane = F.lane;
    for (int m = gw; m < MV; m += NGW) {
        const bool samp = m >= MPR; const int t = samp ? 0 : (m & 2047); const bool hasp = !samp && t > 0;
        const bf16_t* xr = H + (size_t)m * D + 8 * lane;
        f32x4 v[8], pv[8]; float s = 0.f, sp = 0.f;
#pragma unroll
        for (int j = 0; j < 4; ++j) { const u32x4 q = *(const u32x4*)(xr + 512 * j); v[2 * j] = (f32x4){bflo(q.x), bfhi(q.x), bflo(q.y), bfhi(q.y)}; v[2 * j + 1] = (f32x4){bflo(q.z), bfhi(q.z), bflo(q.w), bfhi(q.w)}; }
        if (samp) { const float* pr = A.in[I_SSH] + (size_t)(m - MPR) * D + 8 * lane;
#pragma unroll
            for (int j = 0; j < 4; ++j) { pv[2 * j] = *(const f32x4*)(pr + 512 * j); pv[2 * j + 1] = *(const f32x4*)(pr + 512 * j + 4); }
        } else if (hasp) {
#pragma unroll
            for (int j = 0; j < 4; ++j) { const u32x4 q = *(const u32x4*)(xr - D + 512 * j); pv[2 * j] = (f32x4){bflo(q.x), bfhi(q.x), bflo(q.y), bfhi(q.y)}; pv[2 * j + 1] = (f32x4){bflo(q.z), bfhi(q.z), bflo(q.w), bfhi(q.w)}; }
        } else {
#pragma unroll
            for (int j = 0; j < 8; ++j) pv[j] = (f32x4){0.f, 0.f, 0.f, 0.f};
        }
#pragma unroll
        for (int j = 0; j < 8; ++j) { s += (v[j].x * v[j].x + v[j].y * v[j].y) + (v[j].z * v[j].z + v[j].w * v[j].w); sp += (pv[j].x * pv[j].x + pv[j].y * pv[j].y) + (pv[j].z * pv[j].z + pv[j].w * pv[j].w); }
        const float rs = 1.0f / sqrtf(wave_sum(s) * (1.f / D) + RMS_EPS);
        const float rsp = hasp ? 1.0f / sqrtf(wave_sum(sp) * (1.f / D) + RMS_EPS) : 1.0f;
#pragma unroll
        for (int j = 0; j < 8; ++j) { const f32x4 gg = *(const LAS f32x4*)(G1 + 512 * (j >> 1) + 8 * lane + 4 * (j & 1)); v[j] = v[j] * rs * gg; if (hasp) pv[j] = pv[j] * rsp * gg; pv[j] = pv[j] - v[j]; }
        if (samp || t == SEQ - 1) { float* o = samp ? A.out + O_SHS + (size_t)(m - MPR) * D + 8 * lane : A.out + O_SHP + (size_t)(m >> 11) * D + 8 * lane;
#pragma unroll
            for (int j = 0; j < 4; ++j) { *(f32x4*)(o + 512 * j) = v[2 * j]; *(f32x4*)(o + 512 * j + 4) = v[2 * j + 1]; } }
#pragma unroll 1
        for (int mm = 0; mm < 6; ++mm) {
            bf16_t* dst = (bf16_t*)(ws + T_XR + (size_t)mm * RB2) + (size_t)m * D + 8 * lane;
#pragma unroll
            for (int j = 0; j < 4; ++j) { const f32x4 u0 = *(const LAS f32x4*)(MU + mm * D + 512 * j + 8 * lane), u1 = *(const LAS f32x4*)(MU + mm * D + 512 * j + 8 * lane + 4);
                const f32x4 o0 = v[2 * j] + pv[2 * j] * u0, o1 = v[2 * j + 1] + pv[2 * j + 1] * u1;
                u32x4 w; w.x = cvt_pk_bf16(o0.x, o0.y); w.y = cvt_pk_bf16(o0.z, o0.w); w.z = cvt_pk_bf16(o1.x, o1.y); w.w = cvt_pk_bf16(o1.z, o1.w); *(u32x4*)(dst + 512 * j) = w; }
        }
    }
}

__device__ __forceinline__ void phase_final_norm(const Args& A, const Frame& F) {
    const bf16_t* H = (const bf16_t*)(A.ws + WS_HB); const float* gf = A.in[I_FNG];
    const int gw = F.bid * 8 + F.wave, NGW = F.G * 8, lane = F.lane;
    for (int m = gw; m < MV; m += NGW) {
        const bf16_t* xr = H + (size_t)m * D + 8 * lane; f32x4 v[8]; float s = 0.f;
#pragma unroll
        for (int j = 0; j < 4; ++j) { const u32x4 q = *(const u32x4*)(xr + 512 * j); v[2 * j] = (f32x4){bflo(q.x), bfhi(q.x), bflo(q.y), bfhi(q.y)}; v[2 * j + 1] = (f32x4){bflo(q.z), bfhi(q.z), bflo(q.w), bfhi(q.w)}; }
#pragma unroll
        for (int j = 0; j < 8; ++j) s += (v[j].x * v[j].x + v[j].y * v[j].y) + (v[j].z * v[j].z + v[j].w * v[j].w);
        const float rs = 1.0f / sqrtf(wave_sum(s) * (1.f / D) + RMS_EPS);
        float* o = A.out + (m < MPR ? O_YP + (size_t)m * D : O_YS + (size_t)(m - MPR) * D) + 8 * lane;
#pragma unroll
        for (int j = 0; j < 4; ++j) { *(f32x4*)(o + 512 * j) = v[2 * j] * rs * *(const f32x4*)(gf + 512 * j + 8 * lane); *(f32x4*)(o + 512 * j + 4) = v[2 * j + 1] * rs * *(const f32x4*)(gf + 512 * j + 8 * lane + 4); }
    }
}

constexpr int SL_XA = 0, SL_XR = 2048, SL_XB = 4096, SL_XK = 6144, SL_XQ = 8192, SL_P2T = 8192, SL_BRBT = 8704, SL_BRKT = 9216, SL_AKT = 9728, SL_XN = 10752, SL_VT = 10752, SL_INV = 12800, SL_WC = 12864, SL_BON = 13120, SL_BYTES = 13184, YB_OFF = 8 * SL_BYTES;
static_assert(YB_OFF + 128 * 64 * 4 + 512 + 1024 <= RING_BYTES, "scan LDS");
__device__ __forceinline__ int perm_j(int j) { return (j & 32) + 8 * ((j >> 2) & 3) + 4 * ((j >> 4) & 1) + (j & 3); }
__device__ __forceinline__ float wave_total(float x) {
    x = sum16(x);
    x += __builtin_bit_cast(float, __builtin_amdgcn_update_dpp(0, __builtin_bit_cast(int, x), 0x142, 0xa, 0xf, false));
    x += __builtin_bit_cast(float, __builtin_amdgcn_update_dpp(0, __builtin_bit_cast(int, x), 0x143, 0xc, 0xf, false));
    return __builtin_bit_cast(float, __builtin_amdgcn_readlane(__builtin_bit_cast(int, x), 63));
}
__device__ __forceinline__ void scan_chain_chunked(const Args& A, const Frame& F, int m0, int h, float* Sout) {
    unsigned char* ws = A.ws;
    const bf16_t* RB = (const bf16_t*)(ws + T_R); const bf16_t* KB = (const bf16_t*)(ws + T_K2); const bf16_t* VB = (const bf16_t*)(ws + T_V2); const bf16_t* GG = (const bf16_t*)(ws + T_GG);
    const bf16_t* EW = (const bf16_t*)(ws + T_EW); const bf16_t* AA = (const bf16_t*)(ws + T_AA); bf16_t* YG = (bf16_t*)(ws + T_YG);
    const int tid = F.tid, lane = F.lane, w = F.wave, il = lane & 15, g = lane >> 4, hc = h * HC;
    LAS unsigned char* L = F.lds;
#define SCAN_BAR() do { asm volatile("s_waitcnt lgkmcnt(0)" ::: "memory"); __builtin_amdgcn_s_barrier(); asm volatile("" ::: "memory"); } while (0)
    f32x4 S[4];
#pragma unroll
    for (int jt = 0; jt < 4; ++jt) S[jt] = (f32x4){0.f, 0.f, 0.f, 0.f};
    const float kkw = A.in[I_KK][hc + lane], kaw = A.in[I_KA][hc + lane], rkw = A.in[I_RK][hc + lane];
    u32x4 pr[10];
#define SCAN_LOAD_RAW(btn) do { const size_t lo_ = ((size_t)(m0 + 128 * (btn) + 16 * w) + (lane >> 2)) * D + hc + 16 * (lane & 3); \
        pr[0] = *(const u32x4*)(RB + lo_); pr[1] = *(const u32x4*)(RB + lo_ + 8); pr[2] = *(const u32x4*)(KB + lo_); pr[3] = *(const u32x4*)(KB + lo_ + 8); pr[4] = *(const u32x4*)(EW + lo_); pr[5] = *(const u32x4*)(EW + lo_ + 8); \
        pr[6] = *(const u32x4*)(AA + lo_); pr[7] = *(const u32x4*)(AA + lo_ + 8); pr[8] = *(const u32x4*)(VB + lo_); pr[9] = *(const u32x4*)(VB + lo_ + 8); } while (0)
    SCAN_LOAD_RAW(0);
    LAS float* GNL = (LAS float*)(L + YB_OFF + 128 * 64 * 4);
    if (tid < 64) { GNL[tid] = A.in[I_GNG][hc + tid]; GNL[64 + tid] = A.in[I_GNB][hc + tid]; }
#define SCAN_STAGE_C(bc_) do { const int bc = (bc_); const int tid2 = tid - 256; \
        _Pragma("unroll 2") for (int pass = 0; pass < 4; ++pass) { \
            const int tt = (tid2 >> 3) + 32 * pass, jg = tid2 & 7; const size_t off = (size_t)(m0 + 128 * bc + tt) * D + hc + 8 * jg; \
            const u32x4 g8 = *(const u32x4*)(GG + off), v8 = *(const u32x4*)(VB + off); \
            float y[8]; \
            _Pragma("unroll") for (int j = 0; j < 8; ++j) y[j] = bf1(*(const LAS bf16_t*)(L + YB_OFF + (bc & 1) * 16384 + ((8 * jg + j) * 128 + tt) * 2)); \
            const float bo = *(const LAS float*)(L + YB_OFF + 32768 + 512 + ((bc & 1) * 128 + tt) * 4); \
            const float v[8] = {bflo(v8.x), bfhi(v8.x), bflo(v8.y), bfhi(v8.y), bflo(v8.z), bfhi(v8.z), bflo(v8.w), bfhi(v8.w)}; \
            const float gt[8] = {bflo(g8.x), bfhi(g8.x), bflo(g8.y), bfhi(g8.y), bflo(g8.z), bfhi(g8.z), bflo(g8.w), bfhi(g8.w)}; \
            float s1 = 0.f; \
            _Pragma("unroll") for (int j = 0; j < 8; ++j) s1 += y[j]; \
            s1 = sum8(s1); const float mean = s1 * (1.f / 64.f); float s2 = 0.f; \
            _Pragma("unroll") for (int j = 0; j < 8; ++j) { const float dd = y[j] - mean; s2 += dd * dd; } \
            s2 = sum8(s2); const float rstd = __builtin_amdgcn_rsqf(s2 * (1.f / 64.f) + GN_EPS); \
            float o[8]; \
            _Pragma("unroll") for (int j = 0; j < 8; ++j) o[j] = ((y[j] - mean) * rstd * GNL[8 * jg + j] + GNL[64 + 8 * jg + j] + bo * v[j]) * gt[j]; \
            u32x4 wv; wv.x = pk2(o[0], o[1]); wv.y = pk2(o[2], o[3]); wv.z = pk2(o[4], o[5]); wv.w = pk2(o[6], o[7]); \
            *(u32x4*)(YG + off) = wv; } } while (0)
    for (int bt = 0; bt < SEQ / 128; ++bt) {
        SCAN_BAR();
        {
            LAS unsigned char* sl = L + w * SL_BYTES;
            float xa[16], xb[16], xk[16], xr[16], xn[16], vv[16];
            float E = 0.f, em = 1.0f;
            {
                const int wo = (lane >> 2) * 128 + 32 * (lane & 3);
#pragma unroll
                for (int q5 = 0; q5 < 5; ++q5) { *(LAS u32x4*)(sl + 2048 * q5 + wo) = pr[2 * q5]; *(LAS u32x4*)(sl + 2048 * q5 + wo + 16) = pr[2 * q5 + 1]; }
                asm volatile("s_waitcnt lgkmcnt(0)" ::: "memory");
                if (bt + 1 < SEQ / 128) SCAN_LOAD_RAW(bt + 1);
            }
#pragma unroll
            for (int t = 0; t < 16; ++t) {
                const int ro = t * 128 + 2 * lane;
                const float r = bf1(*(const LAS bf16_t*)(sl + ro)), k = bf1(*(const LAS bf16_t*)(sl + 2048 + ro)), e = bf1(*(const LAS bf16_t*)(sl + 4096 + ro)), a = bf1(*(const LAS bf16_t*)(sl + 6144 + ro)); vv[t] = bf1(*(const LAS bf16_t*)(sl + 8192 + ro));
                const float kkr = k * kkw, kp = k * (1.0f + (a - 1.0f) * kaw);
                xn[t] = kkr; xa[t] = -kkr * em;
                E += e; const float ep = fast_exp(E); em = fast_rcp(ep);
                xb[t] = kkr * a * ep; xk[t] = kp * ep; xr[t] = r * em;
            }
            const float wc = em;
            asm volatile("" ::: "memory");
#define SCAN_WROW(base, arr, mul) do { u32x4 o_; o_.x = cvt_pk_bf16(arr[0] * (mul), arr[1] * (mul)); o_.y = cvt_pk_bf16(arr[2] * (mul), arr[3] * (mul)); o_.z = cvt_pk_bf16(arr[4] * (mul), arr[5] * (mul)); o_.w = cvt_pk_bf16(arr[6] * (mul), arr[7] * (mul)); \
                *(LAS u32x4*)(sl + (base) + lane * 32) = o_; o_.x = cvt_pk_bf16(arr[8] * (mul), arr[9] * (mul)); o_.y = cvt_pk_bf16(arr[10] * (mul), arr[11] * (mul)); o_.z = cvt_pk_bf16(arr[12] * (mul), arr[13] * (mul)); o_.w = cvt_pk_bf16(arr[14] * (mul), arr[15] * (mul)); \
                *(LAS u32x4*)(sl + (base) + lane * 32 + 16) = o_; } while (0)
            SCAN_WROW(SL_XA, xa, 1.0f); SCAN_WROW(SL_XR, xr, 1.0f); SCAN_WROW(SL_XB, xb, 1.0f); SCAN_WROW(SL_XK, xk, 1.0f); SCAN_WROW(SL_XQ, xr, rkw); SCAN_WROW(SL_XN, xn, 1.0f);
            asm volatile("s_waitcnt lgkmcnt(0)" ::: "memory");
            const unsigned slb = (unsigned)(size_t)sl; const int qq = il >> 2, pp = il & 3;
#define SCAN_FRAG(dst, base, ks) do { const s16x4 lo_ = lds_tr16(slb + (base) + (32 * (ks) + 4 * g + qq) * 32 + 8 * pp), hi_ = lds_tr16(slb + (base) + (32 * (ks) + 16 + 4 * g + qq) * 32 + 8 * pp); \
                dst = __builtin_shufflevector(lo_, hi_, 0, 1, 2, 3, 4, 5, 6, 7); } while (0)
            f32x4 n2 = (f32x4){0.f, 0.f, 0.f, 0.f}, dab = n2, dak = n2, drb = n2, drk = n2, dq = n2;
#pragma unroll
            for (int ks = 0; ks < 2; ++ks) { bf16x8 fA, fR, fB, fK, fQ, fN;
                SCAN_FRAG(fA, SL_XA, ks); SCAN_FRAG(fR, SL_XR, ks); SCAN_FRAG(fB, SL_XB, ks); SCAN_FRAG(fK, SL_XK, ks); SCAN_FRAG(fQ, SL_XQ, ks); SCAN_FRAG(fN, SL_XN, ks);
                n2 = __builtin_amdgcn_mfma_f32_16x16x32_bf16(fN, fN, n2, 0, 0, 0); dab = __builtin_amdgcn_mfma_f32_16x16x32_bf16(fA, fB, dab, 0, 0, 0); dak = __builtin_amdgcn_mfma_f32_16x16x32_bf16(fA, fK, dak, 0, 0, 0);
                drb = __builtin_amdgcn_mfma_f32_16x16x32_bf16(fR, fB, drb, 0, 0, 0); drk = __builtin_amdgcn_mfma_f32_16x16x32_bf16(fR, fK, drk, 0, 0, 0); dq = __builtin_amdgcn_mfma_f32_16x16x32_bf16(fQ, fK, dq, 0, 0, 0); }
            asm volatile("" ::: "memory");
            { const int rd = il & 3; const float nd = rd == 0 ? n2[0] : rd == 1 ? n2[1] : rd == 2 ? n2[2] : n2[3], bd = rd == 0 ? dq[0] : rd == 1 ? dq[1] : rd == 2 ? dq[2] : dq[3];
              if ((il >> 2) == g) { *(LAS float*)(sl + SL_INV + 4 * il) = __builtin_amdgcn_rsqf(fmaxf(nd, 1e-24f)); *(LAS float*)(L + YB_OFF + 32768 + 512 + ((bt & 1) * 128 + 16 * w + il) * 4) = bd; } }
            asm volatile("s_waitcnt lgkmcnt(0)" ::: "memory");
            const float inv_s = *(const LAS float*)(sl + SL_INV + 4 * il); const f32x4 inv_t4 = *(const LAS f32x4*)(sl + SL_INV + 16 * g);
            float dabm[4];
            { f32x4 ak4; u32x2 rb2, rk2; float vrb[4], vrk[4];
#pragma unroll
              for (int rr = 0; rr < 4; ++rr) { const int t = 4 * g + rr; dabm[rr] = il < t ? dab[rr] * inv_t4[rr] * inv_s : 0.f; ak4[rr] = il < t ? dak[rr] * inv_t4[rr] : 0.f;
                  vrb[rr] = il <= t ? drb[rr] * inv_s : 0.f; vrk[rr] = il <= t ? drk[rr] : 0.f; }
              rb2.x = cvt_pk_bf16(vrb[0], vrb[1]); rb2.y = cvt_pk_bf16(vrb[2], vrb[3]); rk2.x = cvt_pk_bf16(vrk[0], vrk[1]); rk2.y = cvt_pk_bf16(vrk[2], vrk[3]);
              *(LAS u32x2*)(sl + SL_BRBT + il * 32 + 8 * g) = rb2; *(LAS u32x2*)(sl + SL_BRKT + il * 32 + 8 * g) = rk2; *(LAS f32x4*)(sl + SL_AKT + (il * 16 + 4 * g) * 4) = ak4; }
            asm volatile("s_waitcnt lgkmcnt(0)" ::: "memory");
            float p1[16], p2[16];
            { const f32x4 k0 = *(const LAS f32x4*)(sl + SL_AKT + il * 64), k1 = *(const LAS f32x4*)(sl + SL_AKT + il * 64 + 16), k2 = *(const LAS f32x4*)(sl + SL_AKT + il * 64 + 32), k3 = *(const LAS f32x4*)(sl + SL_AKT + il * 64 + 48);
              const float akr[16] = {k0[0], k0[1], k0[2], k0[3], k1[0], k1[1], k1[2], k1[3], k2[0], k2[1], k2[2], k2[3], k3[0], k3[1], k3[2], k3[3]};
#pragma unroll
              for (int t = 0; t < 16; ++t) {
                const float invt = __builtin_bit_cast(float, __builtin_amdgcn_readlane(__builtin_bit_cast(int, inv_s), t));
                float a1 = xa[t] * invt, a2 = akr[t];
#pragma unroll
                for (int s2 = 0; s2 < 16; ++s2) if (s2 < t) { const float lts = __builtin_bit_cast(float, __builtin_amdgcn_readlane(__builtin_bit_cast(int, dabm[t & 3]), 16 * (t >> 2) + s2)); a1 += lts * p1[s2]; a2 += lts * p2[s2]; }
                p1[t] = a1; p2[t] = a2; xb[t] *= invt;
              } }
            asm volatile("s_waitcnt lgkmcnt(0)" ::: "memory");
            SCAN_WROW(SL_XA, p1, 1.0f); if (lane < 16) SCAN_WROW(SL_P2T, p2, 1.0f);
            SCAN_WROW(SL_XB, xb, wc); SCAN_WROW(SL_XK, xk, wc); SCAN_WROW(SL_VT, vv, 1.0f);
            *(LAS float*)(sl + SL_WC + lane * 4) = wc;
        }
        SCAN_BAR();
        if (w < 4) {
            const int qq = il >> 2, pp = il & 3;
            bf16x8 nP0, nP1, nP2; u32x2 nV;
#define SCAN_LDB(c_) do { LAS unsigned char* sl = L + (c_) * SL_BYTES; const unsigned slb = (unsigned)(size_t)sl; \
                SCAN_FRAG(nP0, SL_XA, 0); SCAN_FRAG(nP1, SL_XA, 1); \
                { const s16x4 p2l_ = lds_tr16(slb + SL_P2T + (4 * g + qq) * 32 + 8 * pp); const s16x4 z4_ = {0, 0, 0, 0}; nP2 = __builtin_shufflevector(p2l_, z4_, 0, 1, 2, 3, 4, 5, 6, 7); } \
                nV = *(const LAS u32x2*)(sl + SL_VT + (16 * w + il) * 32 + 8 * g); } while (0)
            SCAN_LDB(0);
#pragma unroll 1
            for (int c = 0; c < 8; ++c) {
                const bf16x8 aP0 = nP0, aP1 = nP1, aP2 = nP2; const u32x2 vf = nV;
                bf16x8 aR0, aR1, aR2, aS[4]; f32x4 wc4[4];
                {
                    LAS unsigned char* sl = L + c * SL_BYTES; const unsigned slb = (unsigned)(size_t)sl;
#pragma unroll
                    for (int jt = 0; jt < 4; ++jt) { const u32x2 sb = *(const LAS u32x2*)(sl + SL_XB + (16 * jt + il) * 32 + 8 * g), sk = *(const LAS u32x2*)(sl + SL_XK + (16 * jt + il) * 32 + 8 * g);
                        u32x4 as4; as4.x = sb.x; as4.y = sb.y; as4.z = sk.x; as4.w = sk.y; aS[jt] = __builtin_bit_cast(bf16x8, as4); wc4[jt] = *(const LAS f32x4*)(sl + SL_WC + (16 * jt + 4 * g) * 4); }
                    SCAN_FRAG(aR0, SL_XR, 0); SCAN_FRAG(aR1, SL_XR, 1);
                    const s16x4 rbl = lds_tr16(slb + SL_BRBT + (4 * g + qq) * 32 + 8 * pp), rkl = lds_tr16(slb + SL_BRKT + (4 * g + qq) * 32 + 8 * pp);
                    aR2 = __builtin_shufflevector(rbl, rkl, 0, 1, 2, 3, 4, 5, 6, 7);
                }
                if (c + 1 < 8) SCAN_LDB(c + 1);
                u32x4 b0, b1;
                b0.x = cvt_pk_bf16(S[0][0], S[0][1]); b0.y = cvt_pk_bf16(S[0][2], S[0][3]); b0.z = cvt_pk_bf16(S[1][0], S[1][1]); b0.w = cvt_pk_bf16(S[1][2], S[1][3]);
                b1.x = cvt_pk_bf16(S[2][0], S[2][1]); b1.y = cvt_pk_bf16(S[2][2], S[2][3]); b1.z = cvt_pk_bf16(S[3][0], S[3][1]); b1.w = cvt_pk_bf16(S[3][2], S[3][3]);
                const bf16x8 Bs0 = __builtin_bit_cast(bf16x8, b0), Bs1 = __builtin_bit_cast(bf16x8, b1);
                u32x4 bv; bv.x = vf.x; bv.y = vf.y; bv.z = 0u; bv.w = 0u;
                const f32x4 zz = (f32x4){0.f, 0.f, 0.f, 0.f};
                const f32x4 Ua = __builtin_amdgcn_mfma_f32_16x16x32_bf16(aP0, Bs0, zz, 0, 0, 0), Ub = __builtin_amdgcn_mfma_f32_16x16x32_bf16(aP1, Bs1, zz, 0, 0, 0),
                            Uc = __builtin_amdgcn_mfma_f32_16x16x32_bf16(aP2, __builtin_bit_cast(bf16x8, bv), zz, 0, 0, 0);
                const f32x4 U = (Ua + Ub) + Uc;
                u32x4 buv; buv.x = cvt_pk_bf16(U[0], U[1]); buv.y = cvt_pk_bf16(U[2], U[3]); buv.z = vf.x; buv.w = vf.y;
                const bf16x8 Buv = __builtin_bit_cast(bf16x8, buv);
#pragma unroll
                for (int jt = 0; jt < 4; ++jt) S[jt] = __builtin_amdgcn_mfma_f32_16x16x32_bf16(aS[jt], Buv, S[jt] * wc4[jt], 0, 0, 0);
                const f32x4 Ya = __builtin_amdgcn_mfma_f32_16x16x32_bf16(aR0, Bs0, zz, 0, 0, 0), Yb = __builtin_amdgcn_mfma_f32_16x16x32_bf16(aR1, Bs1, zz, 0, 0, 0), Yc = __builtin_amdgcn_mfma_f32_16x16x32_bf16(aR2, Buv, zz, 0, 0, 0);
                const f32x4 Y = (Ya + Yb) + Yc;
                { u32x2 yw; yw.x = cvt_pk_bf16(Y[0], Y[1]); yw.y = cvt_pk_bf16(Y[2], Y[3]); *(LAS u32x2*)(L + YB_OFF + (bt & 1) * 16384 + ((16 * w + il) * 128 + 16 * c + 4 * g) * 2) = yw; }
            }
#undef SCAN_LDB
        } else if (bt > 0) { SCAN_STAGE_C(bt - 1); }
    }
    SCAN_BAR();
    if (w >= 4) { SCAN_STAGE_C(SEQ / 128 - 1); }
#undef SCAN_STAGE_C
#undef SCAN_BAR
#undef SCAN_LOAD_RAW
#undef SCAN_WROW
#undef SCAN_FRAG
    if (w < 4) {
#pragma unroll
        for (int jt = 0; jt < 4; ++jt) *(f32x4*)(Sout + (16 * w + il) * 64 + 16 * jt + 4 * g) = S[jt];
    }
}

__device__ __forceinline__ void scan_sample_wave(const Args& A, const Frame& F, int u) {
    unsigned char* ws = A.ws;
    const bf16_t* RB = (const bf16_t*)(ws + T_R); const bf16_t* KB = (const bf16_t*)(ws + T_K2); const bf16_t* VB = (const bf16_t*)(ws + T_V2); const bf16_t* GG = (const bf16_t*)(ws + T_GG);
    const bf16_t* EW = (const bf16_t*)(ws + T_EW); const bf16_t* AA = (const bf16_t*)(ws + T_AA); bf16_t* YG = (bf16_t*)(ws + T_YG);
    const int lane = F.lane, b = u >> 5, h = u & 31, hc = h * HC; const size_t off = (size_t)(MPR + b) * D + hc + lane;
    const float* Sin = A.in[I_SWKV] + ((size_t)u * HC + lane) * HC; float* Sout = A.out + O_WKVS + ((size_t)u * HC + lane) * HC;
    f32x4 S4[16];
#pragma unroll
    for (int q = 0; q < 16; ++q) S4[q] = *(const f32x4*)(Sin + 4 * q);
    const float r = bf1(RB[off]), k = bf1(KB[off]), v = bf1(VB[off]), e = bf1(EW[off]), a = bf1(AA[off]), gg = bf1(GG[off]);
    const float kkr = k * A.in[I_KK][hc + lane]; const float kk = kkr * __builtin_amdgcn_rsqf(fmaxf(wave_total(kkr * kkr), 1e-24f));
    const float kp = k * (1.0f + (a - 1.0f) * A.in[I_KA][hc + lane]);
    const float bonus = wave_total(r * kp * A.in[I_RK][hc + lane]);
    const float wd = fast_exp(-e), at = -kk, btv = kk * a;
#define RL(x, j) __builtin_bit_cast(float, __builtin_amdgcn_readlane(__builtin_bit_cast(int, x), j))
    float sa = 0.f;
#pragma unroll
    for (int q = 0; q < 16; ++q)
#pragma unroll
        for (int c = 0; c < 4; ++c) sa += S4[q][c] * RL(at, 4 * q + c);
    float y = 0.f;
#pragma unroll
    for (int q = 0; q < 16; ++q) {
#pragma unroll
        for (int c = 0; c < 4; ++c) { const int j = 4 * q + c; S4[q][c] = S4[q][c] * RL(wd, j) + (sa * RL(btv, j) + v * RL(kp, j)); y += S4[q][c] * RL(r, j); }
        *(f32x4*)(Sout + 4 * q) = S4[q]; }
#undef RL
    const float mean = wave_total(y) * (1.f / 64.f); const float dd = y - mean; const float rstd = 1.0f / sqrtf(wave_total(dd * dd) * (1.f / 64.f) + GN_EPS);
    YG[off] = (bf16_t)f2bf((dd * rstd * A.in[I_GNG][hc + lane] + A.in[I_GNB][hc + lane] + bonus * v) * gg);
}
__device__ __forceinline__ void phase_scan(const Args& A, const Frame& F) {
    for (int u = F.bid; u < NBATCH * NHC; u += F.G) { const int b = u >> 5, h = u & 31;
        scan_chain_chunked(A, F, b * SEQ, h, A.out + O_WKVP + (size_t)u * HC * HC); }
    __syncthreads();
    for (int u = F.bid * 8 + F.wave; u < NS * NHC; u += F.G * 8) scan_sample_wave(A, F, u);
}

constexpr int N_PHASES = 13;
__global__ void __launch_bounds__(512, 2) mega_fwd(Args args) {
    extern __shared__ __attribute__((aligned(16))) unsigned char lds_raw[];
    Frame F;
    F.lds = (LAS unsigned char*)lds_raw;
    F.tid = threadIdx.x; F.lane = F.tid & 63; F.wave = __builtin_amdgcn_readfirstlane(F.tid >> 6);
    F.G = gridDim.x; F.bid = blockIdx.x;
    unsigned char* ws = args.ws;
    for (int u = F.tid; u < (LDS_BYTES - LDSCTL_OFF) / 4; u += 512) ((LAS unsigned*)(F.lds + LDSCTL_OFF))[u] = 0u;
    __syncthreads();
    volatile LAS unsigned* MISC = (volatile LAS unsigned*)(F.lds + MISC_OFF);
    XcdBarrier bar = xcd_barrier_post((unsigned*)(ws + WS_CTL) + 4096, MISC + 8);
    const int lo = args.ph_lo, hi = args.ph_hi;
#ifndef PHASE_MASK
#define PHASE_MASK 0xFFFF
#endif
#define IN(k) (((PHASE_MASK >> (k)) & 1) && lo <= (k) && (k) < hi)
#define SEAM(k) do { if (IN(k) && IN((k) + 1)) xcd_barrier(bar); } while (0)

    if (IN(0)) { phase_prologue(args, F); } SEAM(0);

    if (IN(1)) {
        { SchedSimple S; S.init(MPR / 256, NIN / 256, F.G, F.bid); S.A = (const char*)ws + T_XN0; S.B = (const char*)ws + WS_WIN; S.tstep = (size_t)256 * D * 2;
          EpiG1 E{ws, args.out}; pg8::gemm_phase(F.lds, D, S, E); skinny_gemm(F, D, NIN / 256, S, E); }
        { SchedSimple S; S.init(MPR / 256, D / 256, F.G, F.bid); S.A = (const char*)ws + WS_PB; S.B = (const char*)ws + WS_WPROJ; S.tstep = (size_t)256 * PLE * 2;
          EpiBf16 E{(bf16_t*)(ws + WS_PP), D}; pg8::gemm_phase(F.lds, PLE, S, E); skinny_gemm(F, PLE, D / 256, S, E); }
    } SEAM(1);

    if (IN(2)) { phase_attn(args, F); __syncthreads(); phase_attn_naive(args, F); } SEAM(2);
    if (IN(3)) { phase_merge_bmix(args, F); } SEAM(3);

    if (IN(4)) {
        SchedSimple S; S.init(MPR / 256, D / 256, F.G, F.bid); S.A = (const char*)ws + T_A2; S.B = (const char*)ws + WS_WOUT; S.tstep = (size_t)256 * D * 2;
        EpiRes<true> E{args.in[I_XP], args.in[I_XS], nullptr, (bf16_t*)(ws + WS_HA)}; pg8::gemm_phase(F.lds, D, S, E); skinny_gemm(F, D, D / 256, S, E);
    } SEAM(4);

    if (IN(5)) {
        SchedSimple S; S.init(MPR / 256, D / 256, F.G, F.bid); S.A = (const char*)ws + WS_HA; S.B = (const char*)ws + WS_WGATE; S.tstep = (size_t)256 * D * 2;
        EpiGate E{(const bf16_t*)(ws + WS_HA), (bf16_t*)(ws + WS_HB), (const bf16_t*)(ws + WS_PP)}; pg8::gemm_phase(F.lds, D, S, E); skinny_gemm(F, D, D / 256, S, E);
    } SEAM(5);

    if (IN(6)) { phase_rms_mix(args, F); } SEAM(6);

    if (IN(7)) {
        SchedG4 S; S.init(MPR / 256, 34, F.G, F.bid); S.ws = ws;
        EpiG4 E{ws}; pg8::gemm_phase(F.lds, D, S, E); skinny_gemm(F, D, 34, S, E, (MPR / 256 * 34) % 256);
        if (F.G == 256) { SchedSimple S2; S2.init(MPR / 256, D / 256, 128, F.bid >= 128 ? F.bid - 128 : 1 << 20); S2.A = (const char*)ws + WS_PB + (size_t)MP * PLE * 2; S2.B = (const char*)ws + WS_WPROJ + (size_t)D * PLE * 2; S2.tstep = (size_t)256 * PLE * 2;
          EpiBf16 E2{(bf16_t*)(ws + WS_PP), D}; pg8::gemm_phase(F.lds, PLE, S2, E2); skinny_gemm(F, PLE, D / 256, S2, E2, 128); }
    } SEAM(7);

    if (IN(8)) {
        SchedSimple S; S.init(MPR / 256, 4096 / 256, F.G, F.bid); S.A = (const char*)ws + T_HL; S.B = (const char*)ws + WS_WL2; S.tstep = (size_t)256 * 256 * 2;
        SchedL2 S8; S8.init(MPR / 256, 4096 / 256, F.G, F.bid); S8.A = (const char*)ws + T_HL; S8.B = (const char*)ws + WS_WL2;
        EpiL2 E{ws, args.in[I_W0], args.in[I_A0]}; pg8::gemm_phase<256>(F.lds, 128 + ((int)F.G >> 12), S8, E); skinny_gemm(F, 256, 4096 / 256, S, E);
    } SEAM(8);

    if (IN(9)) { phase_scan(args, F); } SEAM(9);

    if (IN(10)) {
        { SchedSimple S; S.init(MPR / 256, D / 256, F.G, F.bid); S.A = (const char*)ws + T_YG; S.B = (const char*)ws + WS_WR + (size_t)4 * D * D * 2; S.tstep = (size_t)256 * D * 2;
          EpiRes<false> E{nullptr, nullptr, (const bf16_t*)(ws + WS_HB), (bf16_t*)(ws + WS_HA)}; pg8::gemm_phase(F.lds, D, S, E); skinny_gemm(F, D, D / 256, S, E); }
    } SEAM(10);

    if (IN(11)) {
        SchedSimple S; S.init(MPR / 256, D / 256, F.G, F.bid); S.A = (const char*)ws + WS_HA; S.B = (const char*)ws + WS_WGATE + (size_t)D * D * 2; S.tstep = (size_t)256 * D * 2;
        EpiGate E{(const bf16_t*)(ws + WS_HA), (bf16_t*)(ws + WS_HB), (const bf16_t*)(ws + WS_PP)}; pg8::gemm_phase(F.lds, D, S, E); skinny_gemm(F, D, D / 256, S, E);
    } SEAM(11);

    if (IN(12)) { phase_final_norm(args, F); }
#undef IN
#undef SEAM
}

extern "C" void kernel_launch(void* const* d_in, const int* in_sizes, int n_in, void* d_out, int out_size, void* d_ws, size_t ws_size, hipStream_t stream) {
    static int grid = 0;
    if (grid == 0) {
        if (n_in != 36 || out_size != (int)O_END || ws_size < WS_END) { fprintf(stderr, "kernel_launch: unexpected shapes: n_in %d out %d ws %zu (need %zu)\n", n_in, out_size, ws_size, (size_t)WS_END); grid = -1; return; }
        int dev = 0, cus = 0, per_cu = 0;
        if (hipGetDevice(&dev) != hipSuccess || hipDeviceGetAttribute(&cus, hipDeviceAttributeMultiprocessorCount, dev) != hipSuccess) { grid = -1; return; }
        if (hipFuncSetAttribute((const void*)mega_fwd, hipFuncAttributeMaxDynamicSharedMemorySize, LDS_BYTES) != hipSuccess) { fprintf(stderr, "kernel_launch: hipFuncSetAttribute failed\n"); grid = -1; return; }
        if (hipOccupancyMaxActiveBlocksPerMultiprocessor(&per_cu, (const void*)mega_fwd, 512, LDS_BYTES) != hipSuccess || per_cu < 1) { fprintf(stderr, "kernel_launch: occupancy query says %d\n", per_cu); }
        (void)hipGetLastError();
        grid = cus;
    }
    if (grid < 0) return;
    (void)hipMemsetAsync((char*)d_ws + WS_CTL, 0, CTL_ZERO_BYTES, stream);
    Args a{};
    for (int i = 0; i < 36; ++i) a.in[i] = (const float*)d_in[i];
    a.out = (float*)d_out; a.ws = (unsigned char*)d_ws;
#if N_LAUNCH_MODE == 1
    a.ph_lo = 0; a.ph_hi = N_PHASES;
    hipLaunchKernelGGL(mega_fwd, dim3(grid), dim3(512), LDS_BYTES, stream, a);
#else
    for (int k = 0; k < N_PHASES; ++k) { a.ph_lo = k; a.ph_hi = k + 1; hipLaunchKernelGGL(mega_fwd, dim3(grid), dim3(512), LDS_BYTES, stream, a); }
#endif
}
```

```cpp
#include <hip/hip_runtime.h>
#include <cstdio>
#include <cstdint>

#define LAS __attribute__((address_space(3)))
#define GAS __attribute__((address_space(1)))
typedef unsigned short bf16_t;
typedef short bf16x8 __attribute__((ext_vector_type(8)));
typedef float f32x4 __attribute__((ext_vector_type(4)));
typedef float f32x2 __attribute__((ext_vector_type(2)));
typedef unsigned u32x4 __attribute__((ext_vector_type(4)));
typedef unsigned u32x2 __attribute__((ext_vector_type(2)));

#ifndef N_LAUNCH_MODE
#define N_LAUNCH_MODE 1
#endif

constexpr int D = 2048, NBATCH = 8, SEQ = 2048, MPR = NBATCH * SEQ  , NS = 32, MV = MPR + NS  , MP = 16640  ;
constexpr int AW = 1024, NIN = 7168, PLE = 256, HC = 64  , NHC = 32;
constexpr float RMS_EPS = 1e-6f, LN_EPS = 1e-5f, GN_EPS = 64e-5f;

__device__ __forceinline__ unsigned f2bf(float f) { unsigned u = __builtin_bit_cast(unsigned, f); return (u + 0x7fffu + ((u >> 16) & 1u)) >> 16; }
__device__ __forceinline__ unsigned pk2(float lo, float hi) { return f2bf(lo) | (f2bf(hi) << 16); }
typedef __bf16 bf16x2_t __attribute__((ext_vector_type(2)));
__device__ __forceinline__ unsigned cvt_pk_bf16(float lo, float hi) { const f32x2 v = {lo, hi}; const bf16x2_t b = __builtin_convertvector(v, bf16x2_t); return __builtin_bit_cast(unsigned, b); }
__device__ __forceinline__ float bflo(unsigned u) { return __builtin_bit_cast(float, u << 16); }
__device__ __forceinline__ float bfhi(unsigned u) { return __builtin_bit_cast(float, u & 0xffff0000u); }
__device__ __forceinline__ float bf1(bf16_t b) { return __builtin_bit_cast(float, ((unsigned)b) << 16); }
__device__ __forceinline__ float fast_rcp(float x) { return __builtin_amdgcn_rcpf(x); }
__device__ __forceinline__ float fast_exp(float x) { return __builtin_amdgcn_exp2f(x * 1.4426950408889634f); }
__device__ __forceinline__ float sigmoidf_(float x) { return fast_rcp(1.0f + fast_exp(-x)); }
__device__ __forceinline__ float siluf_(float x) { return x * sigmoidf_(x); }
__device__ __forceinline__ float gelu_tanh_(float x) { const float z = 1.5957691216057308f * (x + 0.044715f * x * x * x); return x * sigmoidf_(z); }
__device__ __forceinline__ float tanhf_(float x) { return 2.0f * sigmoidf_(2.0f * x) - 1.0f; }
__device__ __forceinline__ float wave_sum(float v) {
#pragma unroll
    for (int o = 1; o < 64; o <<= 1) v += __shfl_xor(v, o);
    return v;
}
__device__ __forceinline__ float wave_max(float v) {
#pragma unroll
    for (int o = 1; o < 64; o <<= 1) v = fmaxf(v, __shfl_xor(v, o));
    return v;
}
template <int CTRL> __device__ __forceinline__ float dpp_f(float x) { return __builtin_bit_cast(float, __builtin_amdgcn_update_dpp(0, __builtin_bit_cast(int, x), CTRL, 0xf, 0xf, true)); }
__device__ __forceinline__ float sum8(float x) {
    x += dpp_f<0xB1>(x); x += dpp_f<0x4E>(x); x += dpp_f<0x141>(x); return x;
}
__device__ __forceinline__ float sum16(float x) {
    x += dpp_f<0x128>(x); x += dpp_f<0x124>(x); x += dpp_f<0x122>(x); x += dpp_f<0x121>(x); return x;
}

namespace pg8 {
constexpr int BM = 256, BK = 64, HALF = 128, HTB = HALF * BK * 2, STAGE_BYTES = 8 * HTB, NXCD = 8, WGM = 2;
__host__ __device__ __forceinline__ int lds_byte(int r, int c) { const int st = (r >> 4) * 2 + (c >> 5), rr = r & 15, cc = c & 31, ob = rr * 64 + cc * 2; return st * 1024 + (ob ^ (((ob >> 9) & 1) << 5)); }
__host__ __device__ __forceinline__ void stage_rc(int b, int& R, int& C) { const int st = b / 1024, sb = b % 1024, swz = sb ^ (((sb >> 9) & 1) << 5); R = (st >> 1) * 16 + swz / 64; C = (st & 1) * 32 + (swz % 64) / 2; }
__host__ __device__ __forceinline__ int perm32(int rho) { const int n = rho >> 4, i = rho & 15; return 8 * (i >> 2) + 4 * n + (i & 3); }

struct Unit { int pm, pn; };

struct TileOrder {
    int nM, nN, nwg, G, c;
    __device__ __forceinline__ void init(int nM_, int nN_, int G_, int c_) { nM = nM_; nN = nN_; nwg = nM * nN; G = G_; c = c_; }
    __device__ __forceinline__ bool next(int i, Unit& u) const {
        const long L = (long)i * G + c; if (L >= nwg) return false;
        int wgid = (int)L; { const int q = nwg / NXCD, r = nwg % NXCD, xcd = wgid % NXCD, off = wgid / NXCD; wgid = (xcd < r ? xcd * (q + 1) : r * (q + 1) + (xcd - r) * q) + off; }
        const int nig = WGM * nN, gid = wgid / nig, fm = gid * WGM, gsz = (nM - fm) < WGM ? (nM - fm) : WGM;
        u.pm = fm + ((wgid % nig) % gsz); u.pn = (wgid % nig) / gsz; return true;
    }
};

template <int LDK = 0, class Epi, class Sched>
__device__ __forceinline__ void gemm_phase(LAS unsigned char* lds, const int K, const Sched& S, const Epi& E) {
    const int ldk = LDK ? LDK : K;
    const int tid = threadIdx.x, wid = __builtin_amdgcn_readfirstlane(tid >> 6), lane = tid & 63, wr = wid >> 2, wc = wid & 3, fr = lane & 15, fq = lane >> 4;
    const int nt = K / BK;
    unsigned voffA[2], voffB[2];
#pragma unroll
    for (int i = 0; i < 2; ++i) { int R, C; stage_rc(tid * 16 + i * 8192, R, C); const int Rb = (R & ~31) + perm32(R & 31);
        voffA[i] = (unsigned)(R * ldk + C) * 2u; voffB[i] = (unsigned)(Rb * ldk + C) * 2u; }
    const size_t kstep = (size_t)(BK * 2);
    const size_t hstep = (size_t)HALF * ldk * 2;
    const unsigned ldsw = (unsigned)wid * 1024u;
    const int aoff = lds_byte(wr * 64 + fr, fq * 8), boff = lds_byte(wc * 32 + fr, fq * 8);
#define PG8_SA(b, h) (((b) * 2 + (h)) * HTB)
#define PG8_SB(b, h) ((4 + (b) * 2 + (h)) * HTB)
#define PG8_STAGE(bufoff, gbase, voff) do { _Pragma("unroll") for (int _i = 0; _i < 2; ++_i) \
        __builtin_amdgcn_global_load_lds((const unsigned*)((const char*)(gbase) + (voff)[_i]), (LAS unsigned*)(lds + (bufoff) + ldsw + _i * 8192), 16, 0, 0); } while (0)
#define PG8_LDA(dst, b, h) do { _Pragma("unroll") for (int m = 0; m < 4; ++m) _Pragma("unroll") for (int k = 0; k < 2; ++k) dst[m][k] = *(const LAS bf16x8*)(lds + PG8_SA(b, h) + aoff + m * 2048 + k * 1024); } while (0)
#define PG8_LDB(dst, b, h) do { _Pragma("unroll") for (int n = 0; n < 2; ++n) _Pragma("unroll") for (int k = 0; k < 2; ++k) dst[n][k] = *(const LAS bf16x8*)(lds + PG8_SB(b, h) + boff + n * 2048 + k * 1024); } while (0)
#define PG8_MMA(ai, bj, At, Bt) do { __builtin_amdgcn_s_setprio(1); _Pragma("unroll") for (int m = 0; m < 4; ++m) _Pragma("unroll") for (int n = 0; n < 2; ++n) _Pragma("unroll") for (int k = 0; k < 2; ++k) \
        acc[ai][bj][m][n] = __builtin_amdgcn_mfma_f32_16x16x32_bf16(Bt[n][k], At[m][k], acc[ai][bj][m][n], 0, 0, 0); __builtin_amdgcn_s_setprio(0); } while (0)
#define PG8_WAIT_V(n) asm volatile("s_waitcnt vmcnt(" #n ")" ::: "memory")
#define PG8_WAIT_L(n) asm volatile("s_waitcnt lgkmcnt(" #n ")" ::: "memory")
#define PG8_BAR __builtin_amdgcn_s_barrier()
#define PG8_SCHED __builtin_amdgcn_sched_barrier(0)
    Unit cur, nxt; int ui = 0;
    if (!S.next(0, cur)) return;
    f32x4 acc[2][2][4][2];
#pragma unroll
    for (int a = 0; a < 2; ++a)
#pragma unroll
        for (int b = 0; b < 2; ++b)
#pragma unroll
            for (int m = 0; m < 4; ++m)
#pragma unroll
                for (int n = 0; n < 2; ++n) acc[a][b][m][n] = (f32x4){0.f, 0.f, 0.f, 0.f};
    bf16x8 At[4][2], B0[2][2], B1[2][2];
    const char* cA = S.a_ptr(cur); const char* cB = S.b_ptr(cur);
    PG8_STAGE(PG8_SB(0, 0), cB, voffB); PG8_STAGE(PG8_SB(0, 1), cB + hstep, voffB); PG8_STAGE(PG8_SA(0, 0), cA, voffA); PG8_STAGE(PG8_SA(0, 1), cA + hstep, voffA);
    if (wr == 1) PG8_BAR;
    PG8_WAIT_V(2); PG8_BAR;
    PG8_STAGE(PG8_SB(1, 0), cB + kstep, voffB); PG8_STAGE(PG8_SA(1, 0), cA + kstep, voffA); PG8_STAGE(PG8_SB(1, 1), cB + hstep + kstep, voffB);
    PG8_WAIT_V(6); PG8_BAR;
    for (;;) {
        const bool has_next = S.next(ui + 1, nxt);
        const char* nA = has_next ? S.a_ptr(nxt) : cA; const char* nB = has_next ? S.b_ptr(nxt) : cB;
#pragma nounroll
        for (int t = 0; t < nt; t += 2) {
            const bool last = (t == nt - 2);
            const char* a1 = cA + (size_t)(t + 1) * kstep;
            const char* a2 = last ? nA : cA + (size_t)(t + 2) * kstep; const char* b2 = last ? nB : cB + (size_t)(t + 2) * kstep;
            const char* a3 = a2 + kstep; const char* b3 = b2 + kstep;
            PG8_LDB(B0, 0, 0); PG8_LDB(B1, 0, 1); PG8_SCHED; PG8_LDA(At, 0, 0); PG8_STAGE(PG8_SA(1, 1), a1 + hstep, voffA);
            PG8_WAIT_V(8); PG8_WAIT_L(0); PG8_BAR; PG8_MMA(0, 0, At, B0); PG8_MMA(0, 1, At, B1); PG8_BAR; PG8_SCHED;
            PG8_LDA(At, 0, 1); PG8_STAGE(PG8_SB(0, 0), b2, voffB); PG8_STAGE(PG8_SB(0, 1), b2 + hstep, voffB); PG8_STAGE(PG8_SA(0, 0), a2, voffA);
            PG8_WAIT_V(8); PG8_WAIT_L(0); PG8_BAR; PG8_MMA(1, 0, At, B0); PG8_MMA(1, 1, At, B1); PG8_BAR; PG8_SCHED;
            PG8_LDB(B0, 1, 0); PG8_LDB(B1, 1, 1); PG8_SCHED; PG8_LDA(At, 1, 0); PG8_STAGE(PG8_SA(0, 1), a2 + hstep, voffA);
            PG8_WAIT_V(8); PG8_WAIT_L(0); PG8_BAR; PG8_MMA(0, 0, At, B0); PG8_MMA(0, 1, At, B1); PG8_BAR; PG8_SCHED;
            PG8_LDA(At, 1, 1); PG8_STAGE(PG8_SB(1, 0), b3, voffB); PG8_STAGE(PG8_SB(1, 1), b3 + hstep, voffB); PG8_STAGE(PG8_SA(1, 0), a3, voffA);
            PG8_WAIT_V(8); PG8_WAIT_L(0); PG8_BAR; PG8_MMA(1, 0, At, B0); PG8_MMA(1, 1, At, B1); PG8_BAR; PG8_SCHED;
        }
        if (wr == 0) PG8_BAR;
        E(acc, cur, wr, wc, fr, fq);
        if (!has_next) break;
#pragma unroll
        for (int a = 0; a < 2; ++a)
#pragma unroll
            for (int b = 0; b < 2; ++b)
#pragma unroll
                for (int m = 0; m < 4; ++m)
#pragma unroll
                    for (int n = 0; n < 2; ++n) acc[a][b][m][n] = (f32x4){0.f, 0.f, 0.f, 0.f};
        cur = nxt; cA = nA; cB = nB; ++ui;
        if (wr == 1) PG8_BAR;
    }
    PG8_WAIT_V(0);
    PG8_BAR;
#undef PG8_SA
#undef PG8_SB
#undef PG8_STAGE
#undef PG8_LDA
#undef PG8_LDB
#undef PG8_MMA
#undef PG8_WAIT_V
#undef PG8_WAIT_L
#undef PG8_BAR
#undef PG8_SCHED
}
}

constexpr size_t MiB = 1u << 20;
constexpr size_t RB2 = (size_t)MP * 2048 * 2;
constexpr size_t RB1 = (size_t)MP * 1024 * 2;
constexpr size_t WS_CTL = 0, CTL_ZERO_BYTES = 64 * 1024;
constexpr size_t WS_STATS = 1 * MiB;
constexpr size_t WS_WIN = 2 * MiB;
constexpr size_t WS_WOUT = WS_WIN + 28 * MiB;
constexpr size_t WS_WGATE = WS_WOUT + 8 * MiB;
constexpr size_t WS_WR = WS_WGATE + 16 * MiB;
constexpr size_t WS_WPROJ = WS_WR + 40 * MiB;
constexpr size_t WS_WL1 = WS_WPROJ + 2 * MiB;
constexpr size_t WS_WL2 = WS_WL1 + 2 * MiB;
constexpr size_t WS_PB = WS_WL2 + 2 * MiB;
constexpr size_t WS_PP = WS_PB + 17 * MiB;
constexpr size_t WS_H = WS_PP + 65 * MiB;
constexpr size_t WS_HA = WS_H, WS_HB = WS_H + 65 * MiB;
constexpr size_t WS_T = WS_H + 130 * MiB;
constexpr size_t T_XN0 = WS_T, T_Q = T_XN0 + RB2, T_K = T_Q + RB1, T_V = T_K + RB1, T_GA = T_V + RB1, T_UB = T_GA + RB1, T_VB = T_UB + RB1, T_GB = T_VB + RB1, T_A2 = T_GB + RB1, T_HB0 = T_A2 + RB2;
constexpr size_t T_OP = WS_T + 430 * MiB;
constexpr size_t T_LSE = WS_T + 530 * MiB;
constexpr size_t T_XR = WS_T, T_XW = T_XR + RB2, T_XK = T_XW + RB2, T_XV = T_XK + RB2, T_XA = T_XV + RB2, T_XG = T_XA + RB2;
constexpr size_t T_EW = WS_T, T_AA = T_EW + RB2, T_YG = T_AA + RB2, T_HB1 = T_YG + RB2;
constexpr size_t T_R = T_XG + RB2, T_K2 = T_R + RB2, T_V2 = T_K2 + RB2, T_GG = T_V2 + RB2, T_HL = T_GG + RB2;
constexpr size_t WS_END = T_HL + (size_t)MP * 256 * 2;
static_assert(WS_END <= 1024 * MiB, "workspace map");

constexpr size_t O_YP = 0, O_YS = O_YP + (size_t)MPR * D, O_AKP = O_YS + (size_t)NS * D, O_AVP = O_AKP + (size_t)MPR * AW, O_AKS = O_AVP + (size_t)MPR * AW,
    O_AVS = O_AKS + (size_t)NS * AW, O_BVS = O_AVS + (size_t)NS * AW, O_WKVP = O_BVS + (size_t)NS * AW, O_SHP = O_WKVP + (size_t)NBATCH * NHC * HC * HC,
    O_WKVS = O_SHP + (size_t)NBATCH * D, O_SHS = O_WKVS + (size_t)NS * NHC * HC * HC, O_END = O_SHS + (size_t)NS * D;
static_assert(O_END == 72597504, "d_out layout");

constexpr int RING_BYTES = 140288, LDSCTL_OFF = RING_BYTES, MISC_OFF = LDSCTL_OFF + 320, LDS_TAB_OFF = RING_BYTES + 1024, LDS_BYTES = 147456;

#define XB_TMO      128
#define XB_XCNT(j)  (256  + 64 * (j))
#define XB_XSUB(j)  (1280 + 64 * (j))
#define XB_XGEN(j)  (2304 + 64 * (j))
#define XB_TOP      3328
#define XB_TOPGEN   3392
#define XCD_BAR_WORDS 3456
#define XB_SPIN_CAP (1u << 20)
__device__ __forceinline__ unsigned xb_ld(unsigned* p)              { return __hip_atomic_load(p, __ATOMIC_RELAXED, __HIP_MEMORY_SCOPE_AGENT); }
__device__ __forceinline__ unsigned xb_add(unsigned* p, unsigned v) { return __hip_atomic_fetch_add(p, v, __ATOMIC_RELAXED, __HIP_MEMORY_SCOPE_AGENT); }
__device__ __forceinline__ unsigned xb_xcc_id() { return (unsigned)__builtin_amdgcn_s_getreg((3 << 11) | 20) & 0xFu; }
#define XB_SPIN(cond, bar) do { unsigned _sp = 0; while (cond) { __builtin_amdgcn_s_sleep(1); \
    if ((++_sp & 255u) == 0u) { if (xb_ld(&(bar)[XB_TMO])) break; if (_sp > XB_SPIN_CAP) { atomicAdd(&(bar)[XB_TMO], 1u); break; } } } } while (0)
struct XcdBarrier { unsigned* bar; unsigned x; volatile LAS unsigned* st; };
__device__ __forceinline__ XcdBarrier xcd_barrier_post(unsigned* bar, volatile LAS unsigned* st) {
    XcdBarrier b; b.bar = bar; b.x = xb_xcc_id(); b.st = st;
    if (threadIdx.x == 0) (void)xb_add(&bar[XB_XCNT(b.x)], 1u);
    return b;
}
__device__ __forceinline__ void xcd_barrier_complete(unsigned* bar, unsigned x, unsigned& nloc, unsigned& nx) {
    const unsigned G = gridDim.x * gridDim.y * gridDim.z;
    unsigned sum, cnt, mine, sp = 0u;
    for (;;) {
        sum = 0u; cnt = 0u; mine = 0u;
#pragma unroll
        for (unsigned j = 0; j < 16; ++j) { const unsigned c = xb_ld(&bar[XB_XCNT(j)]); sum += c; cnt += (c > 0u) ? 1u : 0u; mine = (j == x) ? c : mine; }
        if (sum == G) break;
        __builtin_amdgcn_s_sleep(1);
        if ((++sp & 255u) == 0u) { if (xb_ld(&bar[XB_TMO])) break; if (sp > XB_SPIN_CAP) { atomicAdd(&bar[XB_TMO], 1u); break; } }
    }
    nloc = mine > 0u ? mine : 1u; nx = cnt > 0u ? cnt : 1u;
}
__device__ __forceinline__ void xcd_barrier(const XcdBarrier& b) {
    asm volatile("s_waitcnt vmcnt(0)" ::: "memory");
    __syncthreads();
    if (threadIdx.x == 0) {
        unsigned* bar = b.bar;
        __builtin_amdgcn_s_waitcnt(0);
        unsigned nloc = b.st[0], nx = b.st[1];
        if (nloc == 0u) { xcd_barrier_complete(bar, b.x, nloc, nx); b.st[0] = nloc; b.st[1] = nx; }
        const unsigned old = xb_add(&bar[XB_XSUB(b.x)], 1u);
        const unsigned gen = old / nloc;
        if (old + 1u == (gen + 1u) * nloc) {
            __builtin_amdgcn_fence(__ATOMIC_RELEASE, "agent");
            asm volatile("s_waitcnt vmcnt(0)" ::: "memory");
            const unsigned og = xb_add(&bar[XB_TOP], 1u);
            const unsigned tg = og / nx;
            if (og + 1u == (tg + 1u) * nx) xb_add(&bar[XB_TOPGEN], 1u);
            else XB_SPIN(xb_ld(&bar[XB_TOPGEN]) == tg, bar);
            __builtin_amdgcn_fence(__ATOMIC_ACQUIRE, "agent");
            xb_add(&bar[XB_XGEN(b.x)], 1u);
            asm volatile("s_waitcnt vmcnt(0)" ::: "memory");
        } else {
            XB_SPIN(xb_ld(&bar[XB_XGEN(b.x)]) == gen, bar);
            __builtin_amdgcn_fence(__ATOMIC_ACQUIRE, "agent");
            asm volatile("s_waitcnt vmcnt(0)" ::: "memory");
        }
    }
    __syncthreads();
}

struct Args {
    const float* in[36];
    float* out; unsigned char* ws;
    int ph_lo, ph_hi;
};
enum { I_XP = 0, I_XS, I_CK, I_CV, I_SWKV, I_SSH, I_PP, I_PS, I_NG, I_FNG, I_RELB, I_WIN, I_WOUT, I_BWS, I_BBS, I_BLNG, I_BLNB, I_MU, I_WR, I_WK, I_WV, I_WG, I_WO,
       I_W0, I_W1, I_W2, I_A0, I_A1, I_A2, I_KK, I_KA, I_RK, I_GNG, I_GNB, I_PROJ, I_GATE };

struct Frame {
    LAS unsigned char* lds;
    int tid, lane, wave, G, bid;
};

__device__ __forceinline__ void p0_transpose_item(const float* W, int K, int N, bf16_t* WT, LAS float* scr, int item, int lane) {
    const int nblk = N / 32, kb = item / nblk, nb = item % nblk, k0 = 64 * kb, n0 = 32 * nb;
#pragma unroll 8
    for (int i = 0; i < 32; ++i) { const int kk = 2 * i + (lane >> 5); scr[kk * 33 + (lane & 31)] = W[(size_t)(k0 + kk) * N + n0 + (lane & 31)]; }
    asm volatile("s_waitcnt lgkmcnt(0)" ::: "memory");
    const int c = lane & 7;
#pragma unroll
    for (int j = 0; j < 4; ++j) { const int n = (lane >> 3) + 8 * j; const LAS float* s = scr + (8 * c) * 33 + n;
        u32x4 o; o.x = pk2(s[0 * 33], s[1 * 33]); o.y = pk2(s[2 * 33], s[3 * 33]); o.z = pk2(s[4 * 33], s[5 * 33]); o.w = pk2(s[6 * 33], s[7 * 33]);
        *(u32x4*)(WT + (size_t)(n0 + n) * K + k0 + 8 * c) = o; }
    asm volatile("s_waitcnt lgkmcnt(0)" ::: "memory");
}
__device__ __forceinline__ void p0_transpose_item64(const float* W, int K, int N, bf16_t* WT, LAS float* scr, int item, int lane) {
    const int nblk = N / 64, kb = item / nblk, nb = item % nblk, k0 = 64 * kb, n0 = 64 * nb;
    f32x4 v[16];
#pragma unroll
    for (int i = 0; i < 16; ++i) v[i] = *(const f32x4*)(W + (size_t)(k0 + 4 * i + (lane >> 4)) * N + n0 + 4 * (lane & 15));
#pragma unroll
    for (int i = 0; i < 16; ++i) { LAS float* d = scr + (4 * i + (lane >> 4)) * 65 + 4 * (lane & 15); d[0] = v[i][0]; d[1] = v[i][1]; d[2] = v[i][2]; d[3] = v[i][3]; }
    asm volatile("s_waitcnt lgkmcnt(0)" ::: "memory");
    const int c = lane & 7;
#pragma unroll
    for (int jr = 0; jr < 8; ++jr) { const int n = (lane >> 3) + 8 * jr; const LAS float* sp = scr + (8 * c) * 65 + n;
        u32x4 o; o.x = pk2(sp[0 * 65], sp[1 * 65]); o.y = pk2(sp[2 * 65], sp[3 * 65]); o.z = pk2(sp[4 * 65], sp[5 * 65]); o.w = pk2(sp[6 * 65], sp[7 * 65]);
        *(u32x4*)(WT + (size_t)(n0 + n) * K + k0 + 8 * c) = o; }
    asm volatile("s_waitcnt lgkmcnt(0)" ::: "memory");
}
__device__ __forceinline__ void rms_row_to_bf16(const float* xrow, const float* g, bf16_t* orow, int lane) {
    const float* xr = xrow + 8 * lane; const float* gr = g + 8 * lane;
    f32x4 v[8]; float s = 0.f;
#pragma unroll
    for (int j = 0; j < 4; ++j) { v[2 * j] = *(const f32x4*)(xr + 512 * j); v[2 * j + 1] = *(const f32x4*)(xr + 512 * j + 4); }
#pragma unroll
    for (int j = 0; j < 8; ++j) s += (v[j].x * v[j].x + v[j].y * v[j].y) + (v[j].z * v[j].z + v[j].w * v[j].w);
    const float rs = 1.0f / sqrtf(wave_sum(s) * (1.f / D) + RMS_EPS);
#pragma unroll
    for (int j = 0; j < 4; ++j) { const f32x4 g0 = *(const f32x4*)(gr + 512 * j), g1 = *(const f32x4*)(gr + 512 * j + 4); const f32x4 o0 = v[2 * j] * rs * g0, o1 = v[2 * j + 1] * rs * g1;
        u32x4 w; w.x = cvt_pk_bf16(o0.x, o0.y); w.y = cvt_pk_bf16(o0.z, o0.w); w.z = cvt_pk_bf16(o1.x, o1.y); w.w = cvt_pk_bf16(o1.z, o1.w); *(u32x4*)(orow + 8 * lane + 512 * j) = w; }
}
__device__ __forceinline__ void phase_prologue(const Args& A, const Frame& F) {
    unsigned char* ws = A.ws;
    const int gw = F.bid * 8 + F.wave, NGW = F.G * 8;
    const long gt = (long)F.bid * 512 + F.tid, NGT = (long)F.G * 512;
    LAS float* scr = (LAS float*)(F.lds + F.wave * 17408);
    constexpr int I_IN = (D / 64) * (NIN / 64), I_SQ = (D / 64) * (D / 64), I_PJ = (PLE / 64) * (D / 64), I_L1 = (D / 64) * (96 / 32);
    constexpr int NITEMS = I_IN + 8 * I_SQ + 2 * I_PJ + 2 * I_L1;
    for (int it = gw; it < NITEMS; it += NGW) {
        int r = it;
        if (r < I_IN) { p0_transpose_item64(A.in[I_WIN], D, NIN, (bf16_t*)(ws + WS_WIN), scr, r, F.lane); continue; } r -= I_IN;
        if (r < I_SQ) { p0_transpose_item64(A.in[I_WOUT], D, D, (bf16_t*)(ws + WS_WOUT), scr, r, F.lane); continue; } r -= I_SQ;
        if (r < 2 * I_SQ) { const int l = r / I_SQ; p0_transpose_item64(A.in[I_GATE] + (size_t)l * D * D, D, D, (bf16_t*)(ws + WS_WGATE) + (size_t)l * D * D, scr, r % I_SQ, F.lane); continue; } r -= 2 * I_SQ;
        if (r < 5 * I_SQ) { const int l = r / I_SQ; p0_transpose_item64(A.in[I_WR + l], D, D, (bf16_t*)(ws + WS_WR) + (size_t)l * D * D, scr, r % I_SQ, F.lane); continue; } r -= 5 * I_SQ;
        if (r < 2 * I_PJ) { const int l = r / I_PJ; p0_transpose_item64(A.in[I_PROJ] + (size_t)l * PLE * D, PLE, D, (bf16_t*)(ws + WS_WPROJ) + (size_t)l * D * PLE, scr, r % I_PJ, F.lane); continue; } r -= 2 * I_PJ;
        { const int l = r / I_L1; p0_transpose_item(A.in[l ? I_A1 : I_W1], D, 96, (bf16_t*)(ws + WS_WL1) + (size_t)l * 256 * D, scr, r % I_L1, F.lane); }
    }
    { bf16_t* wl1 = (bf16_t*)(ws + WS_WL1);
      for (long i = gt; i < 2L * 160 * D; i += NGT) { const int l = (int)(i / (160 * D)); const long r = i % (160 * D); wl1[(size_t)l * 256 * D + 96 * D + r] = 0; }
      bf16_t* wl2 = (bf16_t*)(ws + WS_WL2);
      for (int it = gw; it < 128; it += NGW) { const int mtx = it >> 6, n0 = (it & 63) * 32; const float* src = A.in[mtx ? I_A2 : I_W2];
#pragma unroll 8
          for (int i = 0; i < 48; ++i) { const int kk = 2 * i + (F.lane >> 5); scr[kk * 33 + (F.lane & 31)] = src[(size_t)kk * D + n0 + (F.lane & 31)]; }
          asm volatile("s_waitcnt lgkmcnt(0)" ::: "memory");
          const int n = F.lane >> 1, hf = F.lane & 1;
          bf16_t* dst = wl2 + (size_t)(mtx * 2048 + n0 + n) * 256 + 128 * hf;
#pragma unroll
          for (int c = 0; c < 16; ++c) { u32x4 o = (u32x4){0u, 0u, 0u, 0u};
              if (hf == mtx && c < 12) { const LAS float* sp = scr + (8 * c) * 33 + n; o.x = pk2(sp[0 * 33], sp[1 * 33]); o.y = pk2(sp[2 * 33], sp[3 * 33]); o.z = pk2(sp[4 * 33], sp[5 * 33]); o.w = pk2(sp[6 * 33], sp[7 * 33]); }
              *(u32x4*)(dst + 8 * c) = o; }
          asm volatile("s_waitcnt lgkmcnt(0)" ::: "memory");
      } }
    { bf16_t* pb = (bf16_t*)(ws + WS_PB);
      for (long i = gt; i < 2L * MV * 64; i += NGT) { const int l = (int)(i / ((long)MV * 64)); const long r = i % ((long)MV * 64); const int m = (int)(r >> 6), c4 = (int)(r & 63) * 4;
          const float* src = m < MPR ? A.in[I_PP] + ((size_t)l * MPR + m) * PLE + c4 : A.in[I_PS] + ((size_t)l * NS + (m - MPR)) * PLE + c4;
          const f32x4 v = *(const f32x4*)src; u32x2 w; w.x = pk2(v.x, v.y); w.y = pk2(v.z, v.w); *(u32x2*)(pb + ((size_t)l * MP + m) * PLE + c4) = w; } }
    { bf16_t* xn = (bf16_t*)(ws + T_XN0);
      for (int m = gw; m < MV; m += NGW) { const float* xr = m < MPR ? A.in[I_XP] + (size_t)m * D : A.in[I_XS] + (size_t)(m - MPR) * D; rms_row_to_bf16(xr, A.in[I_NG], xn + (size_t)m * D, F.lane); } }
}

#define EPI_LOOP_BEGIN \
    _Pragma("unroll") for (int ai = 0; ai < 2; ++ai) _Pragma("unroll") for (int m = 0; m < 4; ++m) { const int row = u.pm * 256 + ai * 128 + wr * 64 + m * 16 + fr; \
    _Pragma("unroll") for (int bj = 0; bj < 2; ++bj) { const int lc = bj * 128 + wc * 32 + 8 * fq; f32x4 v0 = acc[ai][bj][m][0], v1 = acc[ai][bj][m][1];
#define EPI_LOOP_END } }
__device__ __forceinline__ u32x4 pack8(const f32x4& v0, const f32x4& v1) { u32x4 w; w.x = cvt_pk_bf16(v0[0], v0[1]); w.y = cvt_pk_bf16(v0[2], v0[3]); w.z = cvt_pk_bf16(v1[0], v1[1]); w.w = cvt_pk_bf16(v1[2], v1[3]); return w; }
template <class F> __device__ __forceinline__ void map8(f32x4& v0, f32x4& v1, F f) {
#pragma unroll
    for (int j = 0; j < 4; ++j) { v0[j] = f(v0[j]); v1[j] = f(v1[j]); }
}

struct SchedSimple : pg8::TileOrder {
    const char* A; const char* B; size_t tstep;
    __device__ __forceinline__ const char* a_ptr(const pg8::Unit& u) const { return A + (size_t)u.pm * tstep; }
    __device__ __forceinline__ const char* b_ptr(const pg8::Unit& u) const { return B + (size_t)u.pn * tstep; }
};

struct EpiG1 {
    unsigned char* ws; float* out;
    __device__ __forceinline__ void emit(int pn, int row, int lc, f32x4 v0, f32x4 v1) const {
        const int sec = pn >> 2, cb = (pn & 3) * 256; bf16_t* dst = (bf16_t*)(ws + T_Q + (size_t)sec * RB1) + (size_t)row * AW + cb + lc;
        if (sec == 0) { v0 = v0 * 0.08838834764831845f; v1 = v1 * 0.08838834764831845f; }
        else if (sec <= 2) { float* o = out + (sec == 1 ? O_AKS : O_AVS) + (size_t)(row - MPR) * AW + cb + lc; *(f32x4*)o = v0; *(f32x4*)(o + 4) = v1; }
        else if (sec == 3 || sec == 6) map8(v0, v1, [](float x) { return siluf_(x); });
        else map8(v0, v1, [](float x) { return gelu_tanh_(x); });
        *(u32x4*)dst = pack8(v0, v1);
    }
    __device__ __forceinline__ void operator()(const f32x4 (&acc)[2][2][4][2], const pg8::Unit& u, int wr, int wc, int fr, int fq) const {
        const int sec = u.pn >> 2, cb = (u.pn & 3) * 256;
        bf16_t* dst = (bf16_t*)(ws + T_Q + (size_t)sec * RB1);
        if (sec == 0) {
            EPI_LOOP_BEGIN v0 = v0 * 0.08838834764831845f; v1 = v1 * 0.08838834764831845f; *(u32x4*)(dst + (size_t)row * AW + cb + lc) = pack8(v0, v1); EPI_LOOP_END
        } else if (sec <= 2) {
            float* op = out + (sec == 1 ? O_AKP : O_AVP); float* os = out + (sec == 1 ? O_AKS : O_AVS);
            EPI_LOOP_BEGIN *(u32x4*)(dst + (size_t)row * AW + cb + lc) = pack8(v0, v1);
                if (row < MV) { float* o = row < MPR ? op + (size_t)row * AW + cb + lc : os + (size_t)(row - MPR) * AW + cb + lc; *(f32x4*)o = v0; *(f32x4*)(o + 4) = v1; } EPI_LOOP_END
        } else if (sec == 3 || sec == 6) {
            EPI_LOOP_BEGIN map8(v0, v1, [](float x) { return siluf_(x); }); *(u32x4*)(dst + (size_t)row * AW + cb + lc) = pack8(v0, v1); EPI_LOOP_END
        } else {
            EPI_LOOP_BEGIN map8(v0, v1, [](float x) { return gelu_tanh_(x); }); *(u32x4*)(dst + (size_t)row * AW + cb + lc) = pack8(v0, v1); EPI_LOOP_END
        }
    }
};
struct EpiBf16 {
    bf16_t* O; int ldc;
    __device__ __forceinline__ void emit(int pn, int row, int lc, f32x4 v0, f32x4 v1) const { *(u32x4*)(O + (size_t)row * ldc + pn * 256 + lc) = pack8(v0, v1); }
    __device__ __forceinline__ void operator()(const f32x4 (&acc)[2][2][4][2], const pg8::Unit& u, int wr, int wc, int fr, int fq) const {
        EPI_LOOP_BEGIN *(u32x4*)(O + (size_t)row * ldc + u.pn * 256 + lc) = pack8(v0, v1); EPI_LOOP_END
    }
};
__device__ __forceinline__ void add_bf8(f32x4& v0, f32x4& v1, const u32x4 h) { v0[0] += bflo(h.x); v0[1] += bfhi(h.x); v0[2] += bflo(h.y); v0[3] += bfhi(h.y); v1[0] += bflo(h.z); v1[1] += bfhi(h.z); v1[2] += bflo(h.w); v1[3] += bfhi(h.w); }
template <bool FIRST> struct EpiRes {
    const float* xp; const float* xs; const bf16_t* Hin; bf16_t* Hout;
    __device__ __forceinline__ void emit(int pn, int row, int lc, f32x4 v0, f32x4 v1) const {
        const int col = pn * 256 + lc;
        if (FIRST) { const float* bp = xs + (size_t)(row - MPR) * D + col; v0 = v0 + *(const f32x4*)bp; v1 = v1 + *(const f32x4*)(bp + 4); }
        else add_bf8(v0, v1, *(const u32x4*)(Hin + (size_t)row * D + col));
        *(u32x4*)(Hout + (size_t)row * D + col) = pack8(v0, v1);
    }
    __device__ __forceinline__ void operator()(const f32x4 (&acc)[2][2][4][2], const pg8::Unit& u, int wr, int wc, int fr, int fq) const {
        EPI_LOOP_BEGIN
            const int col = u.pn * 256 + lc;
            if (FIRST) { const float* bp = xp + (size_t)row * D + col; v0 = v0 + *(const f32x4*)bp; v1 = v1 + *(const f32x4*)(bp + 4); }
            else add_bf8(v0, v1, *(const u32x4*)(Hin + (size_t)row * D + col));
            *(u32x4*)(Hout + (size_t)row * D + col) = pack8(v0, v1);
        EPI_LOOP_END
    }
};
struct EpiGate {
    const bf16_t* Hin; bf16_t* Hout; const bf16_t* PP;
    __device__ __forceinline__ void one(int row, int col, f32x4 v0, f32x4 v1) const {
        const u32x4 pp = *(const u32x4*)(PP + (size_t)row * D + col), hh = *(const u32x4*)(Hin + (size_t)row * D + col);
        map8(v0, v1, [](float x) { return sigmoidf_(x); });
        v0[0] *= bflo(pp.x); v0[1] *= bfhi(pp.x); v0[2] *= bflo(pp.y); v0[3] *= bfhi(pp.y); v1[0] *= bflo(pp.z); v1[1] *= bfhi(pp.z); v1[2] *= bflo(pp.w); v1[3] *= bfhi(pp.w);
        add_bf8(v0, v1, hh);
        *(u32x4*)(Hout + (size_t)row * D + col) = pack8(v0, v1);
    }
    __device__ __forceinline__ void emit(int pn, int row, int lc, f32x4 v0, f32x4 v1) const { one(row, pn * 256 + lc, v0, v1); }
    __device__ __forceinline__ void operator()(const f32x4 (&acc)[2][2][4][2], const pg8::Unit& u, int wr, int wc, int fr, int fq) const {
        EPI_LOOP_BEGIN one(row, u.pn * 256 + lc, v0, v1); EPI_LOOP_END
    }
};
struct SchedG4 : pg8::TileOrder {
    unsigned char* ws;
    __device__ __forceinline__ const char* a_ptr(const pg8::Unit& u) const {
        const int g = u.pn >> 3; const size_t off = g == 0 ? T_XR : g == 1 ? T_XK : g == 2 ? T_XV : g == 3 ? T_XG : (u.pn == 32 ? T_XW : T_XA);
        return (const char*)ws + off + (size_t)u.pm * 256 * D * 2; }
    __device__ __forceinline__ const char* b_ptr(const pg8::Unit& u) const {
        const int g = u.pn >> 3;
        if (g < 4) { const int widx = g == 3 ? 3 : g;     return (const char*)ws + WS_WR + (size_t)widx * D * D * 2 + (size_t)(u.pn & 7) * 256 * D * 2; }
        return (const char*)ws + WS_WL1 + (size_t)(u.pn - 32) * 256 * D * 2; }
};
struct EpiG4 {
    unsigned char* ws;
    __device__ __forceinline__ void emit(int pn, int row, int lc, f32x4 v0, f32x4 v1) const {
        const int g = pn >> 3, cb = (pn & 7) * 256;
        if (g < 3) { *(u32x4*)((bf16_t*)(ws + T_R + (size_t)g * RB2) + (size_t)row * D + cb + lc) = pack8(v0, v1); }
        else if (g == 3) { map8(v0, v1, [](float x) { return siluf_(x); }); *(u32x4*)((bf16_t*)(ws + T_GG) + (size_t)row * D + cb + lc) = pack8(v0, v1); }
        else if (lc < 128) { if (pn == 32) map8(v0, v1, [](float x) { return tanhf_(x); }); *(u32x4*)((bf16_t*)(ws + T_HL) + (size_t)row * 256 + (pn == 32 ? 0 : 128) + lc) = pack8(v0, v1); }
    }
    __device__ __forceinline__ void operator()(const f32x4 (&acc)[2][2][4][2], const pg8::Unit& u, int wr, int wc, int fr, int fq) const {
        const int g = u.pn >> 3, cb = (u.pn & 7) * 256;
        if (g < 3) { bf16_t* dst = (bf16_t*)(ws + T_R + (size_t)g * RB2);
            EPI_LOOP_BEGIN *(u32x4*)(dst + (size_t)row * D + cb + lc) = pack8(v0, v1); EPI_LOOP_END
        } else if (g == 3) { bf16_t* dst = (bf16_t*)(ws + T_GG);
            EPI_LOOP_BEGIN map8(v0, v1, [](float x) { return siluf_(x); }); *(u32x4*)(dst + (size_t)row * D + cb + lc) = pack8(v0, v1); EPI_LOOP_END
        } else if (u.pn == 32) { bf16_t* dst = (bf16_t*)(ws + T_HL);
            EPI_LOOP_BEGIN if (bj == 0) { map8(v0, v1, [](float x) { return tanhf_(x); }); *(u32x4*)(dst + (size_t)row * 256 + lc) = pack8(v0, v1); } EPI_LOOP_END
        } else { bf16_t* dst = (bf16_t*)(ws + T_HL);
            EPI_LOOP_BEGIN if (bj == 0) { *(u32x4*)(dst + (size_t)row * 256 + 128 + lc) = pack8(v0, v1); } EPI_LOOP_END
        }
    }
};
struct SchedL2 : pg8::TileOrder {
    const char* A; const char* B;
    __device__ __forceinline__ const char* a_ptr(const pg8::Unit& u) const { return A + (size_t)u.pm * 256 * 256 * 2 + (u.pn >= 8 ? 256 : 0); }
    __device__ __forceinline__ const char* b_ptr(const pg8::Unit& u) const { return B + (size_t)u.pn * 256 * 256 * 2 + (u.pn >= 8 ? 256 : 0); }
};
struct EpiL2 {
    unsigned char* ws; const float* w0; const float* a0;
    __device__ __forceinline__ void emit(int pn, int row, int lc, f32x4 v0, f32x4 v1) const {
        const bool isw = pn < 8; const int col = (pn & 7) * 256 + lc; const float* bias = isw ? w0 : a0; const float sc = isw ? 0.6065306597126334f : 1.0f;
        v0 = v0 + *(const f32x4*)(bias + col); v1 = v1 + *(const f32x4*)(bias + col + 4); map8(v0, v1, [](float x) { return sigmoidf_(x); }); v0 = v0 * sc; v1 = v1 * sc;
        *(u32x4*)((bf16_t*)(ws + (isw ? T_EW : T_AA)) + (size_t)row * D + col) = pack8(v0, v1);
    }
    __device__ __forceinline__ void operator()(const f32x4 (&acc)[2][2][4][2], const pg8::Unit& u, int wr, int wc, int fr, int fq) const {
        const bool isw = u.pn < 8; const int cb = (u.pn & 7) * 256;
        bf16_t* dst = (bf16_t*)(ws + (isw ? T_EW : T_AA)); const float* bias = isw ? w0 : a0; const float sc = isw ? 0.6065306597126334f : 1.0f;
        EPI_LOOP_BEGIN
            const int col = cb + lc; const f32x4 b0 = *(const f32x4*)(bias + col), b1 = *(const f32x4*)(bias + col + 4);
            v0 = v0 + b0; v1 = v1 + b1; map8(v0, v1, [](float x) { return sigmoidf_(x); }); v0 = v0 * sc; v1 = v1 * sc;
            *(u32x4*)(dst + (size_t)row * D + col) = pack8(v0, v1);
        EPI_LOOP_END
    }
};


template <class Epi, class Sched>
__device__ __forceinline__ void skinny_gemm(const Frame& F, const int K, const int nN, const Sched& S, const Epi& E, const int first_idle = 0) {
    const int lane = F.lane, w = F.wave, fr = lane & 15, g = lane >> 4;
    LAS float* RED = (LAS float*)F.lds;
    const int kper = K / 8;
    const int nidle = F.G - first_idle;
    for (int u = F.bid - first_idle; u >= 0 && u < nN * 8; u += nidle) {
        pg8::Unit un; un.pm = MPR / 256; un.pn = u >> 3; const int lc0 = (u & 7) * 32;
        const bf16_t* Ab = (const bf16_t*)S.a_ptr(un) + (size_t)w * kper;
        const bf16_t* Bb = (const bf16_t*)S.b_ptr(un) + (size_t)lc0 * K + (size_t)w * kper;
        const bf16_t* b0 = Bb + (size_t)(8 * (fr >> 2) + (fr & 3)) * K + 8 * g; const bf16_t* b1 = b0 + (size_t)4 * K;
        const bf16_t* a0 = Ab + (size_t)fr * K + 8 * g; const bf16_t* a1 = a0 + (size_t)16 * K;
        f32x4 acc[2][2];
#pragma unroll
        for (int i = 0; i < 2; ++i) { acc[i][0] = (f32x4){0.f, 0.f, 0.f, 0.f}; acc[i][1] = acc[i][0]; }
        for (int k0 = 0; k0 < kper; k0 += 128) {
#pragma unroll
            for (int kk = 0; kk < 4; ++kk) { if (k0 + 32 * kk < kper) {
                const bf16x8 A0 = *(const bf16x8*)(a0 + k0 + 32 * kk), A1 = *(const bf16x8*)(a1 + k0 + 32 * kk), B0 = *(const bf16x8*)(b0 + k0 + 32 * kk), B1 = *(const bf16x8*)(b1 + k0 + 32 * kk);
                acc[0][0] = __builtin_amdgcn_mfma_f32_16x16x32_bf16(B0, A0, acc[0][0], 0, 0, 0); acc[0][1] = __builtin_amdgcn_mfma_f32_16x16x32_bf16(B1, A0, acc[0][1], 0, 0, 0);
                acc[1][0] = __builtin_amdgcn_mfma_f32_16x16x32_bf16(B0, A1, acc[1][0], 0, 0, 0); acc[1][1] = __builtin_amdgcn_mfma_f32_16x16x32_bf16(B1, A1, acc[1][1], 0, 0, 0); } }
        }
        __syncthreads();
#pragma unroll
        for (int i = 0; i < 2; ++i)
#pragma unroll
            for (int j = 0; j < 2; ++j) *(LAS f32x4*)(RED + ((w * 64 + lane) * 16 + (i * 2 + j) * 4)) = acc[i][j];
        __syncthreads();
        if (w < 2) {
            f32x4 v0 = (f32x4){0.f, 0.f, 0.f, 0.f}, v1 = v0;
#pragma unroll
            for (int ww = 0; ww < 8; ++ww) { v0 = v0 + *(const LAS f32x4*)(RED + ((ww * 64 + lane) * 16 + (w * 2 + 0) * 4)); v1 = v1 + *(const LAS f32x4*)(RED + ((ww * 64 + lane) * 16 + (w * 2 + 1) * 4)); }
            E.emit(un.pn, MPR + 16 * w + fr, lc0 + 8 * g, v0, v1);
        }
    }
    __syncthreads();
}

__device__ __forceinline__ int t5_bucket(int dist) {
    if (dist < 16) return dist;
    const float d = (float)dist;
    const int lb = 16 + (int)(logf(d / 16.0f) / 4.852030263919617f * 16.0f);
    return lb < 31 ? lb : 31;
}
__device__ __forceinline__ void phase_attn_naive(const Args& A, const Frame& F) {
    unsigned char* ws = A.ws;
    LAS float* QF = (LAS float*)F.lds; LAS float* SC = QF + 128; LAS float* RED = QF + 1024; LAS float* WR = QF + 640;
    const bf16_t* Qb = (const bf16_t*)(ws + T_Q); const bf16_t* Kb = (const bf16_t*)(ws + T_K); const bf16_t* Vb = (const bf16_t*)(ws + T_V); const bf16_t* GA = (const bf16_t*)(ws + T_GA);
    bf16_t* A2 = (bf16_t*)(ws + T_A2);
    const int gw = F.bid * 8 + F.wave, NGW = F.G * 8, lane = F.lane, tid = F.tid;
    for (int item = F.bid; item < NS * 8; item += F.G) {
        const int b = item >> 3, h = item & 7, m = MPR + b;
        const int uu = tid, p = uu / 129, s = uu - p * 129, dil = p == 0 ? 1 : p == 1 ? 4 : 16; const bool valid = uu < 387;
        f32x4 kr32[32];
        { const int sc_ = valid ? s : 1, dc_ = valid ? dil : 1;
          if (valid && s == 0) { const u32x4* kr = (const u32x4*)(Kb + (size_t)m * AW + h * 128);
#pragma unroll
              for (int c = 0; c < 16; ++c) { const u32x4 kv = kr[c]; kr32[2 * c] = (f32x4){bflo(kv.x), bfhi(kv.x), bflo(kv.y), bfhi(kv.y)}; kr32[2 * c + 1] = (f32x4){bflo(kv.z), bfhi(kv.z), bflo(kv.w), bfhi(kv.w)}; }
          } else { const f32x4* kr = (const f32x4*)(A.in[I_CK] + (((size_t)b * 2048 + (2048 - sc_ * dc_)) * 8 + h) * 128);
#pragma unroll
              for (int c = 0; c < 32; ++c) kr32[c] = kr[c]; } }
        __syncthreads();
        if (tid < 128) QF[tid] = bf1(Qb[(size_t)m * AW + h * 128 + tid]);
        __syncthreads();
        float sc = -1e30f;
        if (valid) { float dot = 0.f;
#pragma unroll
            for (int c = 0; c < 32; ++c) { const f32x4 qa = *(const LAS f32x4*)(QF + 4 * c); dot += qa[0] * kr32[c][0] + qa[1] * kr32[c][1] + qa[2] * kr32[c][2] + qa[3] * kr32[c][3]; }
            sc = dot + A.in[I_RELB][t5_bucket(s * dil) * 8 + h]; }
        const int kg = tid >> 5, e4 = (tid & 31) * 4; f32x4 acc = (f32x4){0.f, 0.f, 0.f, 0.f};
        f32x4 vv[25];
#pragma unroll
        for (int it = 0; it < 25; ++it) { const int u2 = kg + 16 * it; const bool ok = u2 < 387; const int uc = ok ? u2 : 386; const int p2 = uc / 129, s2 = uc - p2 * 129, d2 = p2 == 0 ? 1 : p2 == 1 ? 4 : 16;
            if (s2 == 0) { const u32x2 v2 = *(const u32x2*)(Vb + (size_t)m * AW + h * 128 + e4); vv[it] = (f32x4){bflo(v2.x), bfhi(v2.x), bflo(v2.y), bfhi(v2.y)}; }
            else vv[it] = *(const f32x4*)(A.in[I_CV] + (((size_t)b * 2048 + (2048 - s2 * d2)) * 8 + h) * 128 + e4); }
        float mx = wave_max(sc); if (lane == 0) WR[F.wave] = mx;
        __syncthreads();
        mx = fmaxf(fmaxf(fmaxf(WR[0], WR[1]), fmaxf(WR[2], WR[3])), fmaxf(fmaxf(WR[4], WR[5]), fmaxf(WR[6], WR[7])));
        const float pv = valid ? fast_exp(sc - mx) : 0.f; if (tid < 392) SC[tid] = pv;
        const float ls = wave_sum(pv); if (lane == 0) WR[8 + F.wave] = ls;
        __syncthreads();
        const float l = ((WR[8] + WR[9]) + (WR[10] + WR[11])) + ((WR[12] + WR[13]) + (WR[14] + WR[15]));
        {
#pragma unroll
            for (int it = 0; it < 25; ++it) { const int u2 = kg + 16 * it; const bool ok = u2 < 387; const int uc = ok ? u2 : 386; acc = acc + vv[it] * (ok ? SC[uc] : 0.f); }
        }
        *(LAS f32x4*)(RED + kg * 128 + e4) = acc;
        __syncthreads();
        if (tid < 128) { float o = 0.f;
#pragma unroll
            for (int q = 0; q < 16; ++q) o += RED[q * 128 + tid];
            A2[(size_t)m * D + h * 128 + tid] = (bf16_t)f2bf(o / l * bf1(GA[(size_t)m * AW + h * 128 + tid])); }
    }
    __syncthreads();
    const bf16_t* VBb = (const bf16_t*)(ws + T_VB); const bf16_t* UB = (const bf16_t*)(ws + T_UB); const bf16_t* GB = (const bf16_t*)(ws + T_GB);
    float* ST = (float*)(ws + WS_STATS);
    for (int m = gw; m < MV; m += NGW) {
        const u32x4 a = *(const u32x4*)(VBb + (size_t)m * AW + 8 * lane), c = *(const u32x4*)(VBb + (size_t)m * AW + 512 + 8 * lane);
        float x[16] = {bflo(a.x), bfhi(a.x), bflo(a.y), bfhi(a.y), bflo(a.z), bfhi(a.z), bflo(a.w), bfhi(a.w), bflo(c.x), bfhi(c.x), bflo(c.y), bfhi(c.y), bflo(c.z), bfhi(c.z), bflo(c.w), bfhi(c.w)};
        float s = 0.f;
#pragma unroll
        for (int j = 0; j < 16; ++j) s += x[j];
        const float mean = wave_sum(s) * (1.f / AW); float q = 0.f;
#pragma unroll
        for (int j = 0; j < 16; ++j) { const float d = x[j] - mean; q += d * d; }
        const float rstd = 1.0f / sqrtf(wave_sum(q) * (1.f / AW) + LN_EPS);
        if (lane == 0) { ST[2 * m] = mean; ST[2 * m + 1] = rstd; }
        if (m >= MPR) { const int bs = m - MPR;
#pragma unroll
            for (int j = 0; j < 16; ++j) { const int col = (j < 8 ? 0 : 512) + 8 * lane + (j & 7); const int g = col >> 7;
                const float vn = (x[j] - mean) * rstd * A.in[I_BLNG][col] + A.in[I_BLNB][col];
                A.out[O_BVS + (size_t)bs * AW + col] = vn;
                const float sb = A.in[I_BWS][(size_t)g * 128 * 128] * vn + A.in[I_BBS][g * 128];
                const float ob = bf1(UB[(size_t)m * AW + col]) * sb * bf1(GB[(size_t)m * AW + col]);
                A2[(size_t)m * D + AW + col] = (bf16_t)f2bf(ob); } }
    }
}


typedef short s16x4 __attribute__((ext_vector_type(4)));
__device__ __forceinline__ s16x4 lds_tr16(unsigned byte_addr) { return __builtin_bit_cast(s16x4, __builtin_amdgcn_ds_read_tr16_b64_v4i16((LAS s16x4*)(size_t)byte_addr)); }
__device__ __forceinline__ unsigned koff_sw(int key, int c) { return (unsigned)(key * 256 + ((c ^ (key & 15)) << 4)); }
__device__ __forceinline__ unsigned voff_sw(int key, int c) { return (unsigned)(key * 256 + ((((c >> 1) ^ (key & 7)) << 5) | ((c & 1) << 4))); }
__device__ __forceinline__ void attn_stage(const Frame& F, const bf16_t* Kb, const bf16_t* Vb, int slot, int b, int h, int r, int d, int nsub) {
#pragma unroll
    for (int i = 0; i < 4; ++i) { const int idx = F.tid + 512 * i, kk = idx >> 4, c = idx & 15; const int t = (128 * nsub + kk) * d + r;
        const size_t g = ((size_t)(b * SEQ + t)) * AW + h * 128 + 8 * c;
        const u32x4 kv = *(const u32x4*)(Kb + g), vv = *(const u32x4*)(Vb + g);
        *(LAS u32x4*)(F.lds + slot * 32768 + koff_sw(kk, c)) = kv; *(LAS u32x4*)(F.lds + 65536 + slot * 32768 + voff_sw(kk, c)) = vv; }
}
__device__ __forceinline__ void phase_attn(const Args& A, const Frame& F) {
    unsigned char* ws = A.ws;
    const bf16_t* Qb = (const bf16_t*)(ws + T_Q); const bf16_t* Kb = (const bf16_t*)(ws + T_K); const bf16_t* Vb = (const bf16_t*)(ws + T_V);
    bf16_t* OP = (bf16_t*)(ws + T_OP); float* LSE = (float*)(ws + T_LSE);
    LAS float* T3 = (LAS float*)(F.lds + LDS_TAB_OFF);
    const int lane = F.lane, w = F.wave, ql = lane & 15, g = lane >> 4;
    const int nfb = F.G == 256 ? 12 : 0;
    u32x4 RK[4], RV[4]; bf16x8 RQ[4];
#define ATT_DESC(fb, p_, b_, h_, d_, r_, n_) const int q96_##p_ = (F.bid >> 3) + 32 * ((fb) >> 2), k_##p_ = (fb) & 3, p_ = (q96_##p_ % 12) >> 2, qi_##p_ = ((F.bid & 7) * 8 + q96_##p_ / 12) * 4 + (q96_##p_ & 3), b_ = qi_##p_ >> 5, h_ = (qi_##p_ >> 2) & 7, \
        d_ = p_ == 0 ? 1 : p_ == 1 ? 4 : 16, r_ = p_ == 0 ? 0 : p_ == 1 ? (qi_##p_ & 3) : (qi_##p_ & 3) * 4 + k_##p_, n_ = p_ == 0 ? (qi_##p_ & 3) * 4 + k_##p_ : p_ == 1 ? k_##p_ : 0
#define ATT_LOAD(b_, h_, d_, r_, n_) do { _Pragma("unroll") for (int i_ = 0; i_ < 4; ++i_) { const int idx_ = F.tid + 512 * i_, kk_ = idx_ >> 4, c_ = idx_ & 15; \
            const size_t g_ = ((size_t)((b_) * SEQ + (128 * (n_) + kk_) * (d_) + (r_))) * AW + (h_) * 128 + 8 * c_; RK[i_] = *(const u32x4*)(Kb + g_); RV[i_] = *(const u32x4*)(Vb + g_); } \
        const size_t mq_ = (size_t)((b_) * SEQ + (128 * (n_) + 16 * w + ql) * (d_) + (r_)); \
        _Pragma("unroll") for (int ks_ = 0; ks_ < 4; ++ks_) RQ[ks_] = *(const bf16x8*)(Qb + mq_ * AW + (h_) * 128 + 32 * ks_ + 8 * g); } while (0)
    if (nfb > 0) { ATT_DESC(0, p0, b0, h0, d0, r0, n0); ATT_LOAD(b0, h0, d0, r0, n0); }
    for (int fb = 0; fb < nfb; ++fb) {
        ATT_DESC(fb, p, b, h, d, r, n); const int k = fb & 3;
        {
            const bool has_prev = n > 0; const int so = n & 1, sp = so ^ 1;
            __syncthreads();
#pragma unroll
            for (int i = 0; i < 4; ++i) { const int idx = F.tid + 512 * i, kk = idx >> 4, c = idx & 15;
                *(LAS u32x4*)(F.lds + so * 32768 + koff_sw(kk, c)) = RK[i]; *(LAS u32x4*)(F.lds + 65536 + so * 32768 + voff_sw(kk, c)) = RV[i]; }
            bf16x8 qf[4];
#pragma unroll
            for (int ks = 0; ks < 4; ++ks) qf[ks] = RQ[ks];
            if (k == 0) {
                if (F.tid < 384) { const int steps = 255 - F.tid; T3[F.tid] = (steps >= 0 && steps <= 128) ? A.in[I_RELB][t5_bucket(steps * d) * 8 + h] : -1e30f; }
                if (has_prev) attn_stage(F, Kb, Vb, sp, b, h, r, d, n - 1);
            }
            __syncthreads();
            if (fb + 1 < nfb) { ATT_DESC(fb + 1, pn, bn, hn, dn, rn, nn); ATT_LOAD(bn, hn, dn, rn, nn); }
            const size_t mq = (size_t)(b * SEQ + (128 * n + 16 * w + ql) * d + r);
            f32x4 sc[9]; const int zb = 127 - ql + 4 * g; float mx = -1e30f;
#pragma unroll
            for (int tt = 0; tt < 9; ++tt) {
                const int jt = w + tt; const bool tv = has_prev || jt >= 8;
                f32x4 acc = (f32x4){0.f, 0.f, 0.f, 0.f};
                if (tv) { const unsigned kb = (unsigned)((jt < 8 ? sp : so) * 32768); const int key = ((16 * jt) & 127) + ql;
#pragma unroll
                    for (int ks = 0; ks < 4; ++ks) { const bf16x8 a = *(const LAS bf16x8*)(F.lds + kb + koff_sw(key, 4 * ks + g)); acc = __builtin_amdgcn_mfma_f32_16x16x32_bf16(a, qf[ks], acc, 0, 0, 0); } }
#pragma unroll
                for (int rr = 0; rr < 4; ++rr) { const float sv = tv ? acc[rr] + T3[zb + 16 * tt + rr] : -1e30f; sc[tt][rr] = sv; mx = fmaxf(mx, sv); }
            }
            mx = fmaxf(mx, __shfl_xor(mx, 16)); mx = fmaxf(mx, __shfl_xor(mx, 32));
            float l = 0.f;
#pragma unroll
            for (int tt = 0; tt < 9; ++tt)
#pragma unroll
                for (int rr = 0; rr < 4; ++rr) { const float pv = fast_exp(sc[tt][rr] - mx); sc[tt][rr] = pv; l += pv; }
            l += __shfl_xor(l, 16); l += __shfl_xor(l, 32);
            f32x4 o[8];
#pragma unroll
            for (int et = 0; et < 8; ++et) o[et] = (f32x4){0.f, 0.f, 0.f, 0.f};
            const int qq = ql >> 2, pp = ql & 3;
#pragma unroll
            for (int kk = 0; kk < 5; ++kk) {
                const int t0 = 2 * kk, t1 = 2 * kk + 1;
                u32x4 pw; pw.x = cvt_pk_bf16(sc[t0][0], sc[t0][1]); pw.y = cvt_pk_bf16(sc[t0][2], sc[t0][3]);
                if (t1 < 9) { pw.z = cvt_pk_bf16(sc[t1 < 9 ? t1 : 8][0], sc[t1 < 9 ? t1 : 8][1]); pw.w = cvt_pk_bf16(sc[t1 < 9 ? t1 : 8][2], sc[t1 < 9 ? t1 : 8][3]); } else { pw.z = 0u; pw.w = 0u; }
                const bf16x8 pf = __builtin_bit_cast(bf16x8, pw);
                const int j0 = w + t0, j1 = t1 < 9 ? w + t1 : w + 8;
                const bool v0 = has_prev || j0 >= 8, v1 = has_prev || j1 >= 8;
                const int e0 = v0 ? j0 : 8 + (j0 & 7), e1 = v1 ? j1 : 8 + (j1 & 7);
                const unsigned vb0 = 65536u + (unsigned)((e0 < 8 ? sp : so) * 32768), vb1 = 65536u + (unsigned)((e1 < 8 ? sp : so) * 32768);
                const int key0 = ((16 * e0) & 127) + 4 * g + qq, key1 = ((16 * e1) & 127) + 4 * g + qq;
#pragma unroll
                for (int et = 0; et < 8; ++et) {
                    const s16x4 lo = lds_tr16((unsigned)(size_t)F.lds + vb0 + voff_sw(key0, 2 * et + (pp >> 1)) + 8 * (pp & 1));
                    const s16x4 hi = lds_tr16((unsigned)(size_t)F.lds + vb1 + voff_sw(key1, 2 * et + (pp >> 1)) + 8 * (pp & 1));
                    const bf16x8 af = __builtin_shufflevector(lo, hi, 0, 1, 2, 3, 4, 5, 6, 7);
                    o[et] = __builtin_amdgcn_mfma_f32_16x16x32_bf16(af, pf, o[et], 0, 0, 0);
                }
            }
            const float il = 1.0f / l;
            bf16_t* orow = OP + (size_t)p * MP * AW + mq * AW + h * 128 + 4 * g;
#pragma unroll
            for (int et = 0; et < 8; ++et) { u32x2 wv; wv.x = cvt_pk_bf16(o[et][0] * il, o[et][1] * il); wv.y = cvt_pk_bf16(o[et][2] * il, o[et][3] * il); *(u32x2*)(orow + 16 * et) = wv; }
            if (g == 0) LSE[((size_t)p * MP + mq) * 8 + h] = mx + logf(l);
        }
    }
#undef ATT_DESC
#undef ATT_LOAD
}

__device__ __forceinline__ void phase_bmix_naive(const Args& A, const Frame& F) {
    unsigned char* ws = A.ws;
    LAS float* VN = (LAS float*)F.lds; LAS float* WL = VN + 128 * 128;
    const bf16_t* VBb = (const bf16_t*)(ws + T_VB); const bf16_t* UB = (const bf16_t*)(ws + T_UB); const bf16_t* GB = (const bf16_t*)(ws + T_GB);
    const float* ST = (const float*)(ws + WS_STATS); bf16_t* A2 = (bf16_t*)(ws + T_A2);
    for (int unit = F.bid; unit < NBATCH * 16 * 8; unit += F.G) {
        const int g = unit & 7, n = (unit >> 3) & 15, b = unit >> 7; const int m0 = b * SEQ + n * 128;
        __syncthreads();
        for (int i = F.tid; i < 128 * 128; i += 512) { const int j = i >> 7, c = i & 127; const int col = g * 128 + c;
            const float x = bf1(VBb[(size_t)(m0 + j) * AW + col]);
            VN[i] = (x - ST[2 * (m0 + j)]) * ST[2 * (m0 + j) + 1] * A.in[I_BLNG][col] + A.in[I_BLNB][col];
            WL[i] = A.in[I_BWS][(size_t)g * 128 * 128 + i]; }
        __syncthreads();
        const int c = F.tid & 127, iq = F.tid >> 7;
        for (int ii = 0; ii < 32; ++ii) { const int i = iq + 4 * ii; float s = 0.f;
            for (int j = 0; j <= i; ++j) s += WL[i * 128 + j] * VN[j * 128 + c];
            s += A.in[I_BBS][g * 128 + i];
            const size_t o = (size_t)(m0 + i) * AW + g * 128 + c;
            A2[(size_t)(m0 + i) * D + AW + g * 128 + c] = (bf16_t)f2bf(bf1(UB[o]) * s * bf1(GB[o])); }
    }
}


__device__ __forceinline__ void phase_merge_bmix(const Args& A, const Frame& F) {
    unsigned char* ws = A.ws;
    bf16_t* A2 = (bf16_t*)(ws + T_A2);
    {
        const bf16_t* OP = (const bf16_t*)(ws + T_OP); const float* LSE = (const float*)(ws + T_LSE); const bf16_t* GA = (const bf16_t*)(ws + T_GA);
        const long gt = (long)F.bid * 512 + F.tid, NGT = (long)F.G * 512;
        for (long i = gt; i < (long)MPR * 128; i += NGT) { const int m = (int)(i >> 7), c = (int)(i & 127), h = c >> 4;
            const float l0 = LSE[((size_t)0 * MP + m) * 8 + h], l1 = LSE[((size_t)1 * MP + m) * 8 + h], l2 = LSE[((size_t)2 * MP + m) * 8 + h];
            const float mx = fmaxf(l0, fmaxf(l1, l2)); float w0 = fast_exp(l0 - mx), w1 = fast_exp(l1 - mx), w2 = fast_exp(l2 - mx); const float iw = 1.0f / (w0 + w1 + w2); w0 *= iw; w1 *= iw; w2 *= iw;
            const size_t off = (size_t)m * AW + 8 * c;
            const u32x4 a = *(const u32x4*)(OP + off), bq = *(const u32x4*)(OP + (size_t)MP * AW + off), cq = *(const u32x4*)(OP + (size_t)2 * MP * AW + off), gg = *(const u32x4*)(GA + off);
            u32x4 o;
            o.x = pk2((w0 * bflo(a.x) + w1 * bflo(bq.x) + w2 * bflo(cq.x)) * bflo(gg.x), (w0 * bfhi(a.x) + w1 * bfhi(bq.x) + w2 * bfhi(cq.x)) * bfhi(gg.x));
            o.y = pk2((w0 * bflo(a.y) + w1 * bflo(bq.y) + w2 * bflo(cq.y)) * bflo(gg.y), (w0 * bfhi(a.y) + w1 * bfhi(bq.y) + w2 * bfhi(cq.y)) * bfhi(gg.y));
            o.z = pk2((w0 * bflo(a.z) + w1 * bflo(bq.z) + w2 * bflo(cq.z)) * bflo(gg.z), (w0 * bfhi(a.z) + w1 * bfhi(bq.z) + w2 * bfhi(cq.z)) * bfhi(gg.z));
            o.w = pk2((w0 * bflo(a.w) + w1 * bflo(bq.w) + w2 * bflo(cq.w)) * bflo(gg.w), (w0 * bfhi(a.w) + w1 * bfhi(bq.w) + w2 * bfhi(cq.w)) * bfhi(gg.w));
            *(u32x4*)(A2 + (size_t)m * D + 8 * c) = o; }
    }
    const bf16_t* VBb = (const bf16_t*)(ws + T_VB); const bf16_t* UB = (const bf16_t*)(ws + T_UB); const bf16_t* GB = (const bf16_t*)(ws + T_GB); const float* ST = (const float*)(ws + WS_STATS);
    const int lane = F.lane, w = F.wave, ql = lane & 15, gq = lane >> 4, qq = ql >> 2, pp = ql & 3;
    u32x4 px[4]; float pmean[4], prstd[4];
#define BMIX_FETCH(unit_) do { const int gch_ = (unit_) & 7, m0_ = ((unit_) >> 7) * SEQ + (((unit_) >> 3) & 15) * 128; \
        _Pragma("unroll") for (int i_ = 0; i_ < 4; ++i_) { const int idx_ = F.tid + 512 * i_, j_ = idx_ >> 4, c_ = idx_ & 15; \
            px[i_] = *(const u32x4*)(VBb + (size_t)(m0_ + j_) * AW + gch_ * 128 + 8 * c_); pmean[i_] = ST[2 * (m0_ + j_)]; prstd[i_] = ST[2 * (m0_ + j_) + 1]; } } while (0)
    if (F.bid < NBATCH * 16 * 8) BMIX_FETCH(F.bid);
    for (int unit = F.bid; unit < NBATCH * 16 * 8; unit += F.G) {
        const int gch = unit & 7, n = (unit >> 3) & 15, b = unit >> 7; const int m0 = b * SEQ + n * 128;
        __syncthreads();
#pragma unroll
        for (int i = 0; i < 4; ++i) { const int idx = F.tid + 512 * i, j = idx >> 4, c = idx & 15; const int col = gch * 128 + 8 * c;
            const u32x4 x = px[i]; const float mean = pmean[i], rstd = prstd[i];
            const f32x4 ga = *(const f32x4*)(A.in[I_BLNG] + col), gb = *(const f32x4*)(A.in[I_BLNG] + col + 4), ba = *(const f32x4*)(A.in[I_BLNB] + col), bb = *(const f32x4*)(A.in[I_BLNB] + col + 4);
            u32x4 o;
            o.x = pk2((bflo(x.x) - mean) * rstd * ga[0] + ba[0], (bfhi(x.x) - mean) * rstd * ga[1] + ba[1]); o.y = pk2((bflo(x.y) - mean) * rstd * ga[2] + ba[2], (bfhi(x.y) - mean) * rstd * ga[3] + ba[3]);
            o.z = pk2((bflo(x.z) - mean) * rstd * gb[0] + bb[0], (bfhi(x.z) - mean) * rstd * gb[1] + bb[1]); o.w = pk2((bflo(x.w) - mean) * rstd * gb[2] + bb[2], (bfhi(x.w) - mean) * rstd * gb[3] + bb[3]);
            *(LAS u32x4*)(F.lds + voff_sw(j, c)) = o; }
        __syncthreads();
        if (unit + F.G < NBATCH * 16 * 8) BMIX_FETCH(unit + F.G);
        const int i = 16 * w + ql, kmax = (16 * w + 15) >> 5;
        u32x2 pu[8], pg[8];
#pragma unroll
        for (int ct = 0; ct < 8; ++ct) { const size_t o = (size_t)(m0 + i) * AW + gch * 128 + 16 * ct + 4 * gq; pu[ct] = *(const u32x2*)(UB + o); pg[ct] = *(const u32x2*)(GB + o); }
        f32x4 acc[8];
#pragma unroll
        for (int ct = 0; ct < 8; ++ct) acc[ct] = (f32x4){0.f, 0.f, 0.f, 0.f};
        const float* Wrow = A.in[I_BWS] + ((size_t)gch * 128 + i) * 128;
        f32x4 pwa[4], pwb[4];
#pragma unroll
        for (int ks = 0; ks < 4; ++ks) { const int kc = ks <= kmax ? ks : kmax; pwa[ks] = *(const f32x4*)(Wrow + 32 * kc + 4 * gq); pwb[ks] = *(const f32x4*)(Wrow + 32 * kc + 4 * gq + 16); }
#pragma unroll
        for (int ks = 0; ks < 4; ++ks) { if (ks > kmax) break;
            const int ja = 32 * ks + 4 * gq, jb = ja + 16;
            f32x4 wa = pwa[ks], wb = pwb[ks];
#pragma unroll
            for (int e = 0; e < 4; ++e) { if (ja + e > i) wa[e] = 0.f; if (jb + e > i) wb[e] = 0.f; }
            u32x4 pw; pw.x = cvt_pk_bf16(wa[0], wa[1]); pw.y = cvt_pk_bf16(wa[2], wa[3]); pw.z = cvt_pk_bf16(wb[0], wb[1]); pw.w = cvt_pk_bf16(wb[2], wb[3]);
            const bf16x8 bf = __builtin_bit_cast(bf16x8, pw);
            const int ra = 32 * ks + 4 * gq + qq, rb = ra + 16;
#pragma unroll
            for (int ct = 0; ct < 8; ++ct) {
                const s16x4 lo = lds_tr16((unsigned)(size_t)F.lds + voff_sw(ra, 2 * ct + (pp >> 1)) + 8 * (pp & 1));
                const s16x4 hi = lds_tr16((unsigned)(size_t)F.lds + voff_sw(rb, 2 * ct + (pp >> 1)) + 8 * (pp & 1));
                const bf16x8 af = __builtin_shufflevector(lo, hi, 0, 1, 2, 3, 4, 5, 6, 7);
                acc[ct] = __builtin_amdgcn_mfma_f32_16x16x32_bf16(af, bf, acc[ct], 0, 0, 0);
            }
        }
        const float bias = A.in[I_BBS][gch * 128 + i];
#pragma unroll
        for (int ct = 0; ct < 8; ++ct) { const int col = gch * 128 + 16 * ct + 4 * gq;
            const u32x2 u2 = pu[ct], g2 = pg[ct];
            u32x2 wv; wv.x = pk2(bflo(u2.x) * (acc[ct][0] + bias) * bflo(g2.x), bfhi(u2.x) * (acc[ct][1] + bias) * bfhi(g2.x));
            wv.y = pk2(bflo(u2.y) * (acc[ct][2] + bias) * bflo(g2.y), bfhi(u2.y) * (acc[ct][3] + bias) * bfhi(g2.y));
            *(u32x2*)(A2 + (size_t)(m0 + i) * D + AW + col) = wv; }
    }
#undef BMIX_FETCH
}

__device__ __forceinline__ void phase_rms_mix(const Args& A, const Frame& F) {
    unsigned char* ws = A.ws; const bf16_t* H = (const bf16_t*)(ws + WS_HB);
    LAS float* G1 = (LAS float*)F.lds; LAS float* MU = G1 + D;
    for (int i = F.tid; i < D / 4; i += 512) ((LAS f32x4*)G1)[i] = ((const f32x4*)(A.in[I_NG] + D))[i];
    for (int i = F.tid; i < 6 * D / 4; i += 512) ((LAS f32x4*)MU)[i] = ((const f32x4*)A.in[I_MU])[i];
    __syncthreads();
    const int gw = F.bid * 8 + F.wave, NGW = F.G * 8, lane = F.lane;
    for (int m = gw; m < MV; m += NGW) {
        const bool samp = m >= MPR; const int t = samp ? 0 : (m & 2047); const bool hasp = !samp && t > 0;
        const bf16_t* xr = H + (size_t)m * D + 8 * lane;
        f32x4 v[8], pv[8]; float s = 0.f, sp = 0.f;
#pragma unroll
        for (int j = 0; j < 4; ++j) { const u32x4 q = *(const u32x4*)(xr + 512 * j); v[2 * j] = (f32x4){bflo(q.x), bfhi(q.x), bflo(q.y), bfhi(q.y)}; v[2 * j + 1] = (f32x4){bflo(q.z), bfhi(q.z), bflo(q.w), bfhi(q.w)}; }
        if (samp) { const float* pr = A.in[I_SSH] + (size_t)(m - MPR) * D + 8 * lane;
#pragma unroll
            for (int j = 0; j < 4; ++j) { pv[2 * j] = *(const f32x4*)(pr + 512 * j); pv[2 * j + 1] = *(const f32x4*)(pr + 512 * j + 4); }
        } else if (hasp) {
#pragma unroll
            for (int j = 0; j < 4; ++j) { const u32x4 q = *(const u32x4*)(xr - D + 512 * j); pv[2 * j] = (f32x4){bflo(q.x), bfhi(q.x), bflo(q.y), bfhi(q.y)}; pv[2 * j + 1] = (f32x4){bflo(q.z), bfhi(q.z), bflo(q.w), bfhi(q.w)}; }
        } else {
#pragma unroll
            for (int j = 0; j < 8; ++j) pv[j] = (f32x4){0.f, 0.f, 0.f, 0.f};
        }
#pragma unroll
        for (int j = 0; j < 8; ++j) { s += (v[j].x * v[j].x + v[j].y * v[j].y) + (v[j].z * v[j].z + v[j].w * v[j].w); sp += (pv[j].x * pv[j].x + pv[j].y * pv[j].y) + (pv[j].z * pv[j].z + pv[j].w * pv[j].w); }
        const float rs = 1.0f / sqrtf(wave_sum(s) * (1.f / D) + RMS_EPS);
        const float rsp = hasp ? 1.0f / sqrtf(wave_sum(sp) * (1.f / D) + RMS_EPS) : 1.0f;
#pragma unroll
        for (int j = 0; j < 8; ++j) { const f32x4 gg = *(const LAS f32x4*)(G1 + 512 * (j >> 1) + 8 * lane + 4 * (j & 1)); v[j] = v[j] * rs * gg; if (hasp) pv[j] = pv[j] * rsp * gg; pv[j] = pv[j] - v[j]; }
        if (samp || t == SEQ - 1) { float* o = samp ? A.out + O_SHS + (size_t)(m - MPR) * D + 8 * lane : A.out + O_SHP + (size_t)(m >> 11) * D + 8 * lane;
#pragma unroll
            for (int j = 0; j < 4; ++j) { *(f32x4*)(o + 512 * j) = v[2 * j]; *(f32x4*)(o + 512 * j + 4) = v[2 * j + 1]; } }
#pragma unroll 1
        for (int mm = 0; mm < 6; ++mm) {
            bf16_t* dst = (bf16_t*)(ws + T_XR + (size_t)mm * RB2) + (size_t)m * D + 8 * lane;
#pragma unroll
            for (int j = 0; j < 4; ++j) { const f32x4 u0 = *(const LAS f32x4*)(MU + mm * D + 512 * j + 8 * lane), u1 = *(const LAS f32x4*)(MU + mm * D + 512 * j + 8 * lane + 4);
                const f32x4 o0 = v[2 * j] + pv[2 * j] * u0, o1 = v[2 * j + 1] + pv[2 * j + 1] * u1;
                u32x4 w; w.x = cvt_pk_bf16(o0.x, o0.y); w.y = cvt_pk_bf16(o0.z, o0.w); w.z = cvt_pk_bf16(o1.x, o1.y); w.w = cvt_pk_bf16(o1.z, o1.w); *(u32x4*)(dst + 512 * j) = w; }
        }
    }
}

__device__ __forceinline__ void phase_final_norm(const Args& A, const Frame& F) {
    const bf16_t* H = (const bf16_t*)(A.ws + WS_HB); const float* gf = A.in[I_FNG];
    const int gw = F.bid * 8 + F.wave, NGW = F.G * 8, lane = F.lane;
    for (int m = gw; m < MV; m += NGW) {
        const bf16_t* xr = H + (size_t)m * D + 8 * lane; f32x4 v[8]; float s = 0.f;
#pragma unroll
        for (int j = 0; j < 4; ++j) { const u32x4 q = *(const u32x4*)(xr + 512 * j); v[2 * j] = (f32x4){bflo(q.x), bfhi(q.x), bflo(q.y), bfhi(q.y)}; v[2 * j + 1] = (f32x4){bflo(q.z), bfhi(q.z), bflo(q.w), bfhi(q.w)}; }
#pragma unroll
        for (int j = 0; j < 8; ++j) s += (v[j].x * v[j].x + v[j].y * v[j].y) + (v[j].z * v[j].z + v[j].w * v[j].w);
        const float rs = 1.0f / sqrtf(wave_sum(s) * (1.f / D) + RMS_EPS);
        float* o = A.out + (m < MPR ? O_YP + (size_t)m * D : O_YS + (size_t)(m - MPR) * D) + 8 * lane;
#pragma unroll
        for (int j = 0; j < 4; ++j) { *(f32x4*)(o + 512 * j) = v[2 * j] * rs * *(const f32x4*)(gf + 512 * j + 8 * lane); *(f32x4*)(o + 512 * j + 4) = v[2 * j + 1] * rs * *(const f32x4*)(gf + 512 * j + 8 * lane + 4); }
    }
}

constexpr int SL_XA = 0, SL_XR = 2048, SL_XB = 4096, SL_XK = 6144, SL_XQ = 8192, SL_P2T = 8192, SL_BRBT = 8704, SL_BRKT = 9216, SL_AKT = 9728, SL_XN = 10752, SL_VT = 10752, SL_INV = 12800, SL_WC = 12864, SL_BON = 13120, SL_BYTES = 13184, YB_OFF = 8 * SL_BYTES;
static_assert(YB_OFF + 128 * 64 * 4 + 512 + 1024 <= RING_BYTES, "scan LDS");
__device__ __forceinline__ int perm_j(int j) { return (j & 32) + 8 * ((j >> 2) & 3) + 4 * ((j >> 4) & 1) + (j & 3); }
__device__ __forceinline__ float wave_total(float x) {
    x = sum16(x);
    x += __builtin_bit_cast(float, __builtin_amdgcn_update_dpp(0, __builtin_bit_cast(int, x), 0x142, 0xa, 0xf, false));
    x += __builtin_bit_cast(float, __builtin_amdgcn_update_dpp(0, __builtin_bit_cast(int, x), 0x143, 0xc, 0xf, false));
    return __builtin_bit_cast(float, __builtin_amdgcn_readlane(__builtin_bit_cast(int, x), 63));
}
__device__ __forceinline__ void scan_chain_chunked(const Args& A, const Frame& F, int m0, int h, float* Sout) {
    unsigned char* ws = A.ws;
    const bf16_t* RB = (const bf16_t*)(ws + T_R); const bf16_t* KB = (const bf16_t*)(ws + T_K2); const bf16_t* VB = (const bf16_t*)(ws + T_V2); const bf16_t* GG = (const bf16_t*)(ws + T_GG);
    const bf16_t* EW = (const bf16_t*)(ws + T_EW); const bf16_t* AA = (const bf16_t*)(ws + T_AA); bf16_t* YG = (bf16_t*)(ws + T_YG);
    const int tid = F.tid, lane = F.lane, w = F.wave, il = lane & 15, g = lane >> 4, hc = h * HC;
    LAS unsigned char* L = F.lds;
#define SCAN_BAR() do { asm volatile("s_waitcnt lgkmcnt(0)" ::: "memory"); __builtin_amdgcn_s_barrier(); asm volatile("" ::: "memory"); } while (0)
    f32x4 S[4];
#pragma unroll
    for (int jt = 0; jt < 4; ++jt) S[jt] = (f32x4){0.f, 0.f, 0.f, 0.f};
    const float kkw = A.in[I_KK][hc + lane], kaw = A.in[I_KA][hc + lane], rkw = A.in[I_RK][hc + lane];
    u32x4 pr[10];
#define SCAN_LOAD_RAW(btn) do { const size_t lo_ = ((size_t)(m0 + 128 * (btn) + 16 * w) + (lane >> 2)) * D + hc + 16 * (lane & 3); \
        pr[0] = *(const u32x4*)(RB + lo_); pr[1] = *(const u32x4*)(RB + lo_ + 8); pr[2] = *(const u32x4*)(KB + lo_); pr[3] = *(const u32x4*)(KB + lo_ + 8); pr[4] = *(const u32x4*)(EW + lo_); pr[5] = *(const u32x4*)(EW + lo_ + 8); \
        pr[6] = *(const u32x4*)(AA + lo_); pr[7] = *(const u32x4*)(AA + lo_ + 8); pr[8] = *(const u32x4*)(VB + lo_); pr[9] = *(const u32x4*)(VB + lo_ + 8); } while (0)
    SCAN_LOAD_RAW(0);
    LAS float* GNL = (LAS float*)(L + YB_OFF + 128 * 64 * 4);
    if (tid < 64) { GNL[tid] = A.in[I_GNG][hc + tid]; GNL[64 + tid] = A.in[I_GNB][hc + tid]; }
#define SCAN_STAGE_C(bc_) do { const int bc = (bc_); const int tid2 = tid - 256; \
        _Pragma("unroll 2") for (int pass = 0; pass < 4; ++pass) { \
            const int tt = (tid2 >> 3) + 32 * pass, jg = tid2 & 7; const size_t off = (size_t)(m0 + 128 * bc + tt) * D + hc + 8 * jg; \
            const u32x4 g8 = *(const u32x4*)(GG + off), v8 = *(const u32x4*)(VB + off); \
            float y[8]; \
            _Pragma("unroll") for (int j = 0; j < 8; ++j) y[j] = bf1(*(const LAS bf16_t*)(L + YB_OFF + (bc & 1) * 16384 + ((8 * jg + j) * 128 + tt) * 2)); \
            const float bo = *(const LAS float*)(L + YB_OFF + 32768 + 512 + ((bc & 1) * 128 + tt) * 4); \
            const float v[8] = {bflo(v8.x), bfhi(v8.x), bflo(v8.y), bfhi(v8.y), bflo(v8.z), bfhi(v8.z), bflo(v8.w), bfhi(v8.w)}; \
            const float gt[8] = {bflo(g8.x), bfhi(g8.x), bflo(g8.y), bfhi(g8.y), bflo(g8.z), bfhi(g8.z), bflo(g8.w), bfhi(g8.w)}; \
            float s1 = 0.f; \
            _Pragma("unroll") for (int j = 0; j < 8; ++j) s1 += y[j]; \
            s1 = sum8(s1); const float mean = s1 * (1.f / 64.f); float s2 = 0.f; \
            _Pragma("unroll") for (int j = 0; j < 8; ++j) { const float dd = y[j] - mean; s2 += dd * dd; } \
            s2 = sum8(s2); const float rstd = __builtin_amdgcn_rsqf(s2 * (1.f / 64.f) + GN_EPS); \
            float o[8]; \
            _Pragma("unroll") for (int j = 0; j < 8; ++j) o[j] = ((y[j] - mean) * rstd * GNL[8 * jg + j] + GNL[64 + 8 * jg + j] + bo * v[j]) * gt[j]; \
            u32x4 wv; wv.x = pk2(o[0], o[1]); wv.y = pk2(o[2], o[3]); wv.z = pk2(o[4], o[5]); wv.w = pk2(o[6], o[7]); \
            *(u32x4*)(YG + off) = wv; } } while (0)
    for (int bt = 0; bt < SEQ / 128; ++bt) {
        SCAN_BAR();
        {
            LAS unsigned char* sl = L + w * SL_BYTES;
            float xa[16], xb[16], xk[16], xr[16], xn[16], vv[16];
            float E = 0.f, em = 1.0f;
            {
                const int wo = (lane >> 2) * 128 + 32 * (lane & 3);
#pragma unroll
                for (int q5 = 0; q5 < 5; ++q5) { *(LAS u32x4*)(sl + 2048 * q5 + wo) = pr[2 * q5]; *(LAS u32x4*)(sl + 2048 * q5 + wo + 16) = pr[2 * q5 + 1]; }
                asm volatile("s_waitcnt lgkmcnt(0)" ::: "memory");
                if (bt + 1 < SEQ / 128) SCAN_LOAD_RAW(bt + 1);
            }
#pragma unroll
            for (int t = 0; t < 16; ++t) {
                const int ro = t * 128 + 2 * lane;
                const float r = bf1(*(const LAS bf16_t*)(sl + ro)), k = bf1(*(const LAS bf16_t*)(sl + 2048 + ro)), e = bf1(*(const LAS bf16_t*)(sl + 4096 + ro)), a = bf1(*(const LAS bf16_t*)(sl + 6144 + ro)); vv[t] = bf1(*(const LAS bf16_t*)(sl + 8192 + ro));
                const float kkr = k * kkw, kp = k * (1.0f + (a - 1.0f) * kaw);
                xn[t] = kkr; xa[t] = -kkr * em;
                E += e; const float ep = fast_exp(E); em = fast_rcp(ep);
                xb[t] = kkr * a * ep; xk[t] = kp * ep; xr[t] = r * em;
            }
            const float wc = em;
            asm volatile("" ::: "memory");
#define SCAN_WROW(base, arr, mul) do { u32x4 o_; o_.x = cvt_pk_bf16(arr[0] * (mul), arr[1] * (mul)); o_.y = cvt_pk_bf16(arr[2] * (mul), arr[3] * (mul)); o_.z = cvt_pk_bf16(arr[4] * (mul), arr[5] * (mul)); o_.w = cvt_pk_bf16(arr[6] * (mul), arr[7] * (mul)); \
                *(LAS u32x4*)(sl + (base) + lane * 32) = o_; o_.x = cvt_pk_bf16(arr[8] * (mul), arr[9] * (mul)); o_.y = cvt_pk_bf16(arr[10] * (mul), arr[11] * (mul)); o_.z = cvt_pk_bf16(arr[12] * (mul), arr[13] * (mul)); o_.w = cvt_pk_bf16(arr[14] * (mul), arr[15] * (mul)); \
                *(LAS u32x4*)(sl + (base) + lane * 32 + 16) = o_; } while (0)
            SCAN_WROW(SL_XA, xa, 1.0f); SCAN_WROW(SL_XR, xr, 1.0f); SCAN_WROW(SL_XB, xb, 1.0f); SCAN_WROW(SL_XK, xk, 1.0f); SCAN_WROW(SL_XQ, xr, rkw); SCAN_WROW(SL_XN, xn, 1.0f);
            asm volatile("s_waitcnt lgkmcnt(0)" ::: "memory");
            const unsigned slb = (unsigned)(size_t)sl; const int qq = il >> 2, pp = il & 3;
#define SCAN_FRAG(dst, base, ks) do { const s16x4 lo_ = lds_tr16(slb + (base) + (32 * (ks) + 4 * g + qq) * 32 + 8 * pp), hi_ = lds_tr16(slb + (base) + (32 * (ks) + 16 + 4 * g + qq) * 32 + 8 * pp); \
                dst = __builtin_shufflevector(lo_, hi_, 0, 1, 2, 3, 4, 5, 6, 7); } while (0)
            f32x4 n2 = (f32x4){0.f, 0.f, 0.f, 0.f}, dab = n2, dak = n2, drb = n2, drk = n2, dq = n2;
#pragma unroll
            for (int ks = 0; ks < 2; ++ks) { bf16x8 fA, fR, fB, fK, fQ, fN;
                SCAN_FRAG(fA, SL_XA, ks); SCAN_FRAG(fR, SL_XR, ks); SCAN_FRAG(fB, SL_XB, ks); SCAN_FRAG(fK, SL_XK, ks); SCAN_FRAG(fQ, SL_XQ, ks); SCAN_FRAG(fN, SL_XN, ks);
                n2 = __builtin_amdgcn_mfma_f32_16x16x32_bf16(fN, fN, n2, 0, 0, 0); dab = __builtin_amdgcn_mfma_f32_16x16x32_bf16(fA, fB, dab, 0, 0, 0); dak = __builtin_amdgcn_mfma_f32_16x16x32_bf16(fA, fK, dak, 0, 0, 0);
                drb = __builtin_amdgcn_mfma_f32_16x16x32_bf16(fR, fB, drb, 0, 0, 0); drk = __builtin_amdgcn_mfma_f32_16x16x32_bf16(fR, fK, drk, 0, 0, 0); dq = __builtin_amdgcn_mfma_f32_16x16x32_bf16(fQ, fK, dq, 0, 0, 0); }
            asm volatile("" ::: "memory");
            { const int rd = il & 3; const float nd = rd == 0 ? n2[0] : rd == 1 ? n2[1] : rd == 2 ? n2[2] : n2[3], bd = rd == 0 ? dq[0] : rd == 1 ? dq[1] : rd == 2 ? dq[2] : dq[3];
              if ((il >> 2) == g) { *(LAS float*)(sl + SL_INV + 4 * il) = __builtin_amdgcn_rsqf(fmaxf(nd, 1e-24f)); *(LAS float*)(L + YB_OFF + 32768 + 512 + ((bt & 1) * 128 + 16 * w + il) * 4) = bd; } }
            asm volatile("s_waitcnt lgkmcnt(0)" ::: "memory");
            const float inv_s = *(const LAS float*)(sl + SL_INV + 4 * il); const f32x4 inv_t4 = *(const LAS f32x4*)(sl + SL_INV + 16 * g);
            float dabm[4];
            { f32x4 ak4; u32x2 rb2, rk2; float vrb[4], vrk[4];
#pragma unroll
              for (int rr = 0; rr < 4; ++rr) { const int t = 4 * g + rr; dabm[rr] = il < t ? dab[rr] * inv_t4[rr] * inv_s : 0.f; ak4[rr] = il < t ? dak[rr] * inv_t4[rr] : 0.f;
                  vrb[rr] = il <= t ? drb[rr] * inv_s : 0.f; vrk[rr] = il <= t ? drk[rr] : 0.f; }
              rb2.x = cvt_pk_bf16(vrb[0], vrb[1]); rb2.y = cvt_pk_bf16(vrb[2], vrb[3]); rk2.x = cvt_pk_bf16(vrk[0], vrk[1]); rk2.y = cvt_pk_bf16(vrk[2], vrk[3]);
              *(LAS u32x2*)(sl + SL_BRBT + il * 32 + 8 * g) = rb2; *(LAS u32x2*)(sl + SL_BRKT + il * 32 + 8 * g) = rk2; *(LAS f32x4*)(sl + SL_AKT + (il * 16 + 4 * g) * 4) = ak4; }
            asm volatile("s_waitcnt lgkmcnt(0)" ::: "memory");
            float p1[16], p2[16];
            { const f32x4 k0 = *(const LAS f32x4*)(sl + SL_AKT + il * 64), k1 = *(const LAS f32x4*)(sl + SL_AKT + il * 64 + 16), k2 = *(const LAS f32x4*)(sl + SL_AKT + il * 64 + 32), k3 = *(const LAS f32x4*)(sl + SL_AKT + il * 64 + 48);
              const float akr[16] = {k0[0], k0[1], k0[2], k0[3], k1[0], k1[1], k1[2], k1[3], k2[0], k2[1], k2[2], k2[3], k3[0], k3[1], k3[2], k3[3]};
#pragma unroll
              for (int t = 0; t < 16; ++t) {
                const float invt = __builtin_bit_cast(float, __builtin_amdgcn_readlane(__builtin_bit_cast(int, inv_s), t));
                float a1 = xa[t] * invt, a2 = akr[t];
#pragma unroll
                for (int s2 = 0; s2 < 16; ++s2) if (s2 < t) { const float lts = __builtin_bit_cast(float, __builtin_amdgcn_readlane(__builtin_bit_cast(int, dabm[t & 3]), 16 * (t >> 2) + s2)); a1 += lts * p1[s2]; a2 += lts * p2[s2]; }
                p1[t] = a1; p2[t] = a2; xb[t] *= invt;
              } }
            asm volatile("s_waitcnt lgkmcnt(0)" ::: "memory");
            SCAN_WROW(SL_XA, p1, 1.0f); if (lane < 16) SCAN_WROW(SL_P2T, p2, 1.0f);
            SCAN_WROW(SL_XB, xb, wc); SCAN_WROW(SL_XK, xk, wc); SCAN_WROW(SL_VT, vv, 1.0f);
            *(LAS float*)(sl + SL_WC + lane * 4) = wc;
        }
        SCAN_BAR();
        if (w < 4) {
            const int qq = il >> 2, pp = il & 3;
            bf16x8 nP0, nP1, nP2; u32x2 nV;
#define SCAN_LDB(c_) do { LAS unsigned char* sl = L + (c_) * SL_BYTES; const unsigned slb = (unsigned)(size_t)sl; \
                SCAN_FRAG(nP0, SL_XA, 0); SCAN_FRAG(nP1, SL_XA, 1); \
                { const s16x4 p2l_ = lds_tr16(slb + SL_P2T + (4 * g + qq) * 32 + 8 * pp); const s16x4 z4_ = {0, 0, 0, 0}; nP2 = __builtin_shufflevector(p2l_, z4_, 0, 1, 2, 3, 4, 5, 6, 7); } \
                nV = *(const LAS u32x2*)(sl + SL_VT + (16 * w + il) * 32 + 8 * g); } while (0)
            SCAN_LDB(0);
#pragma unroll 1
            for (int c = 0; c < 8; ++c) {
                const bf16x8 aP0 = nP0, aP1 = nP1, aP2 = nP2; const u32x2 vf = nV;
                bf16x8 aR0, aR1, aR2, aS[4]; f32x4 wc4[4];
                {
                    LAS unsigned char* sl = L + c * SL_BYTES; const unsigned slb = (unsigned)(size_t)sl;
#pragma unroll
                    for (int jt = 0; jt < 4; ++jt) { const u32x2 sb = *(const LAS u32x2*)(sl + SL_XB + (16 * jt + il) * 32 + 8 * g), sk = *(const LAS u32x2*)(sl + SL_XK + (16 * jt + il) * 32 + 8 * g);
                        u32x4 as4; as4.x = sb.x; as4.y = sb.y; as4.z = sk.x; as4.w = sk.y; aS[jt] = __builtin_bit_cast(bf16x8, as4); wc4[jt] = *(const LAS f32x4*)(sl + SL_WC + (16 * jt + 4 * g) * 4); }
                    SCAN_FRAG(aR0, SL_XR, 0); SCAN_FRAG(aR1, SL_XR, 1);
                    const s16x4 rbl = lds_tr16(slb + SL_BRBT + (4 * g + qq) * 32 + 8 * pp), rkl = lds_tr16(slb + SL_BRKT + (4 * g + qq) * 32 + 8 * pp);
                    aR2 = __builtin_shufflevector(rbl, rkl, 0, 1, 2, 3, 4, 5, 6, 7);
                }
                if (c + 1 < 8) SCAN_LDB(c + 1);
                u32x4 b0, b1;
                b0.x = cvt_pk_bf16(S[0][0], S[0][1]); b0.y = cvt_pk_bf16(S[0][2], S[0][3]); b0.z = cvt_pk_bf16(S[1][0], S[1][1]); b0.w = cvt_pk_bf16(S[1][2], S[1][3]);
                b1.x = cvt_pk_bf16(S[2][0], S[2][1]); b1.y = cvt_pk_bf16(S[2][2], S[2][3]); b1.z = cvt_pk_bf16(S[3][0], S[3][1]); b1.w = cvt_pk_bf16(S[3][2], S[3][3]);
                const bf16x8 Bs0 = __builtin_bit_cast(bf16x8, b0), Bs1 = __builtin_bit_cast(bf16x8, b1);
                u32x4 bv; bv.x = vf.x; bv.y = vf.y; bv.z = 0u; bv.w = 0u;
                const f32x4 zz = (f32x4){0.f, 0.f, 0.f, 0.f};
                const f32x4 Ua = __builtin_amdgcn_mfma_f32_16x16x32_bf16(aP0, Bs0, zz, 0, 0, 0), Ub = __builtin_amdgcn_mfma_f32_16x16x32_bf16(aP1, Bs1, zz, 0, 0, 0),
                            Uc = __builtin_amdgcn_mfma_f32_16x16x32_bf16(aP2, __builtin_bit_cast(bf16x8, bv), zz, 0, 0, 0);
                const f32x4 U = (Ua + Ub) + Uc;
                u32x4 buv; buv.x = cvt_pk_bf16(U[0], U[1]); buv.y = cvt_pk_bf16(U[2], U[3]); buv.z = vf.x; buv.w = vf.y;
                const bf16x8 Buv = __builtin_bit_cast(bf16x8, buv);
#pragma unroll
                for (int jt = 0; jt < 4; ++jt) S[jt] = __builtin_amdgcn_mfma_f32_16x16x32_bf16(aS[jt], Buv, S[jt] * wc4[jt], 0, 0, 0);
                const f32x4 Ya = __builtin_amdgcn_mfma_f32_16x16x32_bf16(aR0, Bs0, zz, 0, 0, 0), Yb = __builtin_amdgcn_mfma_f32_16x16x32_bf16(aR1, Bs1, zz, 0, 0, 0), Yc = __builtin_amdgcn_mfma_f32_16x16x32_bf16(aR2, Buv, zz, 0, 0, 0);
                const f32x4 Y = (Ya + Yb) + Yc;
                { u32x2 yw; yw.x = cvt_pk_bf16(Y[0], Y[1]); yw.y = cvt_pk_bf16(Y[2], Y[3]); *(LAS u32x2*)(L + YB_OFF + (bt & 1) * 16384 + ((16 * w + il) * 128 + 16 * c + 4 * g) * 2) = yw; }
            }
#undef SCAN_LDB
        } else if (bt > 0) { SCAN_STAGE_C(bt - 1); }
    }
    SCAN_BAR();
    if (w >= 4) { SCAN_STAGE_C(SEQ / 128 - 1); }
#undef SCAN_STAGE_C
#undef SCAN_BAR
#undef SCAN_LOAD_RAW
#undef SCAN_WROW
#undef SCAN_FRAG
    if (w < 4) {
#pragma unroll
        for (int jt = 0; jt < 4; ++jt) *(f32x4*)(Sout + (16 * w + il) * 64 + 16 * jt + 4 * g) = S[jt];
    }
}

__device__ __forceinline__ void scan_sample_wave(const Args& A, const Frame& F, int u) {
    unsigned char* ws = A.ws;
    const bf16_t* RB = (const bf16_t*)(ws + T_R); const bf16_t* KB = (const bf16_t*)(ws + T_K2); const bf16_t* VB = (const bf16_t*)(ws + T_V2); const bf16_t* GG = (const bf16_t*)(ws + T_GG);
    const bf16_t* EW = (const bf16_t*)(ws + T_EW); const bf16_t* AA = (const bf16_t*)(ws + T_AA); bf16_t* YG = (bf16_t*)(ws + T_YG);
    const int lane = F.lane, b = u >> 5, h = u & 31, hc = h * HC; const size_t off = (size_t)(MPR + b) * D + hc + lane;
    const float* Sin = A.in[I_SWKV] + ((size_t)u * HC + lane) * HC; float* Sout = A.out + O_WKVS + ((size_t)u * HC + lane) * HC;
    f32x4 S4[16];
#pragma unroll
    for (int q = 0; q < 16; ++q) S4[q] = *(const f32x4*)(Sin + 4 * q);
    const float r = bf1(RB[off]), k = bf1(KB[off]), v = bf1(VB[off]), e = bf1(EW[off]), a = bf1(AA[off]), gg = bf1(GG[off]);
    const float kkr = k * A.in[I_KK][hc + lane]; const float kk = kkr * __builtin_amdgcn_rsqf(fmaxf(wave_total(kkr * kkr), 1e-24f));
    const float kp = k * (1.0f + (a - 1.0f) * A.in[I_KA][hc + lane]);
    const float bonus = wave_total(r * kp * A.in[I_RK][hc + lane]);
    const float wd = fast_exp(-e), at = -kk, btv = kk * a;
#define RL(x, j) __builtin_bit_cast(float, __builtin_amdgcn_readlane(__builtin_bit_cast(int, x), j))
    float sa = 0.f;
#pragma unroll
    for (int q = 0; q < 16; ++q)
#pragma unroll
        for (int c = 0; c < 4; ++c) sa += S4[q][c] * RL(at, 4 * q + c);
    float y = 0.f;
#pragma unroll
    for (int q = 0; q < 16; ++q) {
#pragma unroll
        for (int c = 0; c < 4; ++c) { const int j = 4 * q + c; S4[q][c] = S4[q][c] * RL(wd, j) + (sa * RL(btv, j) + v * RL(kp, j)); y += S4[q][c] * RL(r, j); }
        *(f32x4*)(Sout + 4 * q) = S4[q]; }
#undef RL
    const float mean = wave_total(y) * (1.f / 64.f); const float dd = y - mean; const float rstd = 1.0f / sqrtf(wave_total(dd * dd) * (1.f / 64.f) + GN_EPS);
    YG[off] = (bf16_t)f2bf((dd * rstd * A.in[I_GNG][hc + lane] + A.in[I_GNB][hc + lane] + bonus * v) * gg);
}
__device__ __forceinline__ void phase_scan(const Args& A, const Frame& F) {
    for (int u = F.bid; u < NBATCH * NHC; u += F.G) { const int b = u >> 5, h = u & 31;
        scan_chain_chunked(A, F, b * SEQ, h, A.out + O_WKVP + (size_t)u * HC * HC); }
    __syncthreads();
    for (int u = F.bid * 8 + F.wave; u < NS * NHC; u += F.G * 8) scan_sample_wave(A, F, u);
}

constexpr int N_PHASES = 13;
__global__ void __launch_bounds__(512, 2) mega_fwd(Args args) {
    extern __shared__ __attribute__((aligned(16))) unsigned char lds_raw[];
    Frame F;
    F.lds = (LAS unsigned char*)lds_raw;
    F.tid = threadIdx.x; F.lane = F.tid & 63; F.wave = __builtin_amdgcn_readfirstlane(F.tid >> 6);
    F.G = gridDim.x; F.bid = blockIdx.x;
    unsigned char* ws = args.ws;
    for (int u = F.tid; u < (LDS_BYTES - LDSCTL_OFF) / 4; u += 512) ((LAS unsigned*)(F.lds + LDSCTL_OFF))[u] = 0u;
    __syncthreads();
    volatile LAS unsigned* MISC = (volatile LAS unsigned*)(F.lds + MISC_OFF);
    XcdBarrier bar = xcd_barrier_post((unsigned*)(ws + WS_CTL) + 4096, MISC + 8);
    const int lo = args.ph_lo, hi = args.ph_hi;
#ifndef PHASE_MASK
#define PHASE_MASK 0xFFFF
#endif
#define IN(k) (((PHASE_MASK >> (k)) & 1) && lo <= (k) && (k) < hi)
#define SEAM(k) do { if (IN(k) && IN((k) + 1)) xcd_barrier(bar); } while (0)

    if (IN(0)) { phase_prologue(args, F); } SEAM(0);

    if (IN(1)) {
        { SchedSimple S; S.init(MPR / 256, NIN / 256, F.G, F.bid); S.A = (const char*)ws + T_XN0; S.B = (const char*)ws + WS_WIN; S.tstep = (size_t)256 * D * 2;
          EpiG1 E{ws, args.out}; pg8::gemm_phase(F.lds, D, S, E); skinny_gemm(F, D, NIN / 256, S, E); }
        { SchedSimple S; S.init(MPR / 256, D / 256, F.G, F.bid); S.A = (const char*)ws + WS_PB; S.B = (const char*)ws + WS_WPROJ; S.tstep = (size_t)256 * PLE * 2;
          EpiBf16 E{(bf16_t*)(ws + WS_PP), D}; pg8::gemm_phase(F.lds, PLE, S, E); skinny_gemm(F, PLE, D / 256, S, E); }
    } SEAM(1);

    if (IN(2)) { phase_attn(args, F); __syncthreads(); phase_attn_naive(args, F); } SEAM(2);
    if (IN(3)) { phase_merge_bmix(args, F); } SEAM(3);

    if (IN(4)) {
        SchedSimple S; S.init(MPR / 256, D / 256, F.G, F.bid); S.A = (const char*)ws + T_A2; S.B = (const char*)ws + WS_WOUT; S.tstep = (size_t)256 * D * 2;
        EpiRes<true> E{args.in[I_XP], args.in[I_XS], nullptr, (bf16_t*)(ws + WS_HA)}; pg8::gemm_phase(F.lds, D, S, E); skinny_gemm(F, D, D / 256, S, E);
    } SEAM(4);

    if (IN(5)) {
        SchedSimple S; S.init(MPR / 256, D / 256, F.G, F.bid); S.A = (const char*)ws + WS_HA; S.B = (const char*)ws + WS_WGATE; S.tstep = (size_t)256 * D * 2;
        EpiGate E{(const bf16_t*)(ws + WS_HA), (bf16_t*)(ws + WS_HB), (const bf16_t*)(ws + WS_PP)}; pg8::gemm_phase(F.lds, D, S, E); skinny_gemm(F, D, D / 256, S, E);
    } SEAM(5);

    if (IN(6)) { phase_rms_mix(args, F); } SEAM(6);

    if (IN(7)) {
        SchedG4 S; S.init(MPR / 256, 34, F.G, F.bid); S.ws = ws;
        EpiG4 E{ws}; pg8::gemm_phase(F.lds, D, S, E); skinny_gemm(F, D, 34, S, E, (MPR / 256 * 34) % 256);
        if (F.G == 256) { SchedSimple S2; S2.init(MPR / 256, D / 256, 128, F.bid >= 128 ? F.bid - 128 : 1 << 20); S2.A = (const char*)ws + WS_PB + (size_t)MP * PLE * 2; S2.B = (const char*)ws + WS_WPROJ + (size_t)D * PLE * 2; S2.tstep = (size_t)256 * PLE * 2;
          EpiBf16 E2{(bf16_t*)(ws + WS_PP), D}; pg8::gemm_phase(F.lds, PLE, S2, E2); skinny_gemm(F, PLE, D / 256, S2, E2, 128); }
    } SEAM(7);

    if (IN(8)) {
        SchedSimple S; S.init(MPR / 256, 4096 / 256, F.G, F.bid); S.A = (const char*)ws + T_HL; S.B = (const char*)ws + WS_WL2; S.tstep = (size_t)256 * 256 * 2;
        SchedL2 S8; S8.init(MPR / 256, 4096 / 256, F.G, F.bid); S8.A = (const char*)ws + T_HL; S8.B = (const char*)ws + WS_WL2;
        EpiL2 E{ws, args.in[I_W0], args.in[I_A0]}; pg8::gemm_phase<256>(F.lds, 128 + ((int)F.G >> 12), S8, E); skinny_gemm(F, 256, 4096 / 256, S, E);
    } SEAM(8);

    if (IN(9)) { phase_scan(args, F); } SEAM(9);

    if (IN(10)) {
        { SchedSimple S; S.init(MPR / 256, D / 256, F.G, F.bid); S.A = (const char*)ws + T_YG; S.B = (const char*)ws + WS_WR + (size_t)4 * D * D * 2; S.tstep = (size_t)256 * D * 2;
          EpiRes<false> E{nullptr, nullptr, (const bf16_t*)(ws + WS_HB), (bf16_t*)(ws + WS_HA)}; pg8::gemm_phase(F.lds, D, S, E); skinny_gemm(F, D, D / 256, S, E); }
    } SEAM(10);

    if (IN(11)) {
        SchedSimple S; S.init(MPR / 256, D / 256, F.G, F.bid); S.A = (const char*)ws + WS_HA; S.B = (const char*)ws + WS_WGATE + (size_t)D * D * 2; S.tstep = (size_t)256 * D * 2;
        EpiGate E{(const bf16_t*)(ws + WS_HA), (bf16_t*)(ws + WS_HB), (const bf16_t*)(ws + WS_PP)}; pg8::gemm_phase(F.lds, D, S, E); skinny_gemm(F, D, D / 256, S, E);
    } SEAM(11);

    if (IN(12)) { phase_final_norm(args, F); }
#undef IN
#undef SEAM
}

extern "C" void kernel_launch(void* const* d_in, const int* in_sizes, int n_in, void* d_out, int out_size, void* d_ws, size_t ws_size, hipStream_t stream) {
    static int grid = 0;
    if (grid == 0) {
        if (n_in != 36 || out_size != (int)O_END || ws_size < WS_END) { fprintf(stderr, "kernel_launch: unexpected shapes: n_in %d out %d ws %zu (need %zu)\n", n_in, out_size, ws_size, (size_t)WS_END); grid = -1; return; }
        int dev = 0, cus = 0, per_cu = 0;
        if (hipGetDevice(&dev) != hipSuccess || hipDeviceGetAttribute(&cus, hipDeviceAttributeMultiprocessorCount, dev) != hipSuccess) { grid = -1; return; }
        if (hipFuncSetAttribute((const void*)mega_fwd, hipFuncAttributeMaxDynamicSharedMemorySize, LDS_BYTES) != hipSuccess) { fprintf(stderr, "kernel_launch: hipFuncSetAttribute failed\n"); grid = -1; return; }
        if (hipOccupancyMaxActiveBlocksPerMultiprocessor(&per_cu, (const void*)mega_fwd, 512, LDS_BYTES) != hipSuccess || per_cu < 1) { fprintf(stderr, "kernel_launch: occupancy query says %d\n", per_cu); }
        (void)hipGetLastError();
        grid = cus;
    }
    if (grid < 0) return;
    (void)hipMemsetAsync((char*)d_ws + WS_CTL, 0, CTL_ZERO_BYTES, stream);
    Args a{};
    for (int i = 0; i < 36; ++i) a.in[i] = (const float*)d_in[i];
    a.out = (float*)d_out; a.ws = (unsigned char*)d_ws;
#if N_LAUNCH_MODE == 1
    a.ph_lo = 0; a.ph_hi = N_PHASES;
    hipLaunchKernelGGL(mega_fwd, dim3(grid), dim3(512), LDS_BYTES, stream, a);
#else
    for (int k = 0; k < N_PHASES; ++k) { a.ph_lo = k; a.ph_hi = k + 1; hipLaunchKernelGGL(mega_fwd, dim3(grid), dim3(512), LDS_BYTES, stream, a); }
#endif
}
```
